# Optimizing an MI355X kernel written in HIP

```python
import math
import jax, jax.numpy as jnp
from jax import lax
import numpy as np

D_MODEL = 1024
BATCH = 2
SEQ = 8192
DEPTH = 4
DEC_BATCH = 128
DEC_SEQ = 1
PAST_LEN = 8192
PAGE_SIZE = 128

N_MIXERS = 2
N_SSM_LAYERS = (DEPTH + N_MIXERS - 1) // N_MIXERS
N_SWA_LAYERS = DEPTH - N_SSM_LAYERS
SSM_GROUP = 16
SSM_GROUPS = D_MODEL // SSM_GROUP
SSM_STATE = 64
SSM_CHUNK = 128
DT_MIN = 1e-3
DT_MAX = 1e-1
HEAD_DIM = 64
N_HEADS = D_MODEL // HEAD_DIM
N_KV_HEADS = 4
GQA = N_HEADS // N_KV_HEADS
WINDOW = 128
QKV_WIDTH = (N_HEADS + 2 * N_KV_HEADS) * HEAD_DIM
N_MEM = 256
CA_HEADS = 4
CA_HEAD_DIM = D_MODEL // CA_HEADS
D_FF = ((8 * D_MODEL // 3 + 127) // 128) * 128
FFN_RES = 0.5
EPS = 1e-6
NEG = -1e30

kernel_name = "s5_swa_sink_macaron_memory_decoder_step"


def rmsnorm(x, g):
    xf = x.astype(jnp.float32)
    r = lax.rsqrt(jnp.mean(xf * xf, axis=-1, keepdims=True) + EPS)
    return (xf * r * g.astype(jnp.float32)).astype(x.dtype)


def swiglu(x, w_in, w_out):
    gate, up = jnp.split(x @ w_in, 2, axis=-1)
    return (jax.nn.silu(gate) * up) @ w_out


def _cplx_combine(e1, e2):
    a1r, a1i, b1r, b1i = e1
    a2r, a2i, b2r, b2i = e2
    return (a2r * a1r - a2i * a1i,
            a2r * a1i + a2i * a1r,
            a2r * b1r - a2i * b1i + b2r,
            a2r * b1i + a2i * b1r + b2i)


def s5_mixer(u, h0_re, h0_im, a_re, a_im, log_dt, b_re, b_im, c_re, c_im, d_skip, w_glu, b_glu):
    bsz, L, _ = u.shape
    f32 = jnp.float32
    uf = u.astype(f32)
    dt = jnp.exp(log_dt.astype(f32))[:, None]
    ar, ai = a_re.astype(f32), a_im.astype(f32)
    mag = jnp.exp(ar * dt)
    lr, li = mag * jnp.cos(ai * dt), mag * jnp.sin(ai * dt)
    den = ar * ar + ai * ai
    nr, ni = lr - 1.0, li
    zr = (nr * ar + ni * ai) / den
    zi = (ni * ar - nr * ai) / den
    br, bi = b_re.astype(f32), b_im.astype(f32)
    bbar_r = zr[..., None] * br - zi[..., None] * bi
    bbar_i = zr[..., None] * bi + zi[..., None] * br
    cr, ci = c_re.astype(f32), c_im.astype(f32)
    chunk = SSM_CHUNK if L % SSM_CHUNK == 0 else L
    nc = L // chunk
    uc = uf.reshape(bsz, nc, chunk, SSM_GROUPS, SSM_GROUP).transpose(1, 0, 2, 3, 4)

    def step(carry, u_blk):
        hr, hi = carry
        bur = jnp.einsum('bcgs,gps->bcgp', u_blk, bbar_r)
        bui = jnp.einsum('bcgs,gps->bcgp', u_blk, bbar_i)
        alr = jnp.broadcast_to(lr, bur.shape)
        ali = jnp.broadcast_to(li, bur.shape)
        pr, pi, xr, xi = lax.associative_scan(_cplx_combine, (alr, ali, bur, bui), axis=1)
        hr_t = xr + pr * hr[:, None] - pi * hi[:, None]
        hi_t = xi + pr * hi[:, None] + pi * hr[:, None]
        y = jnp.einsum('bcgp,gsp->bcgs', hr_t, cr) - jnp.einsum('bcgp,gsp->bcgs', hi_t, ci)
        return (hr_t[:, -1], hi_t[:, -1]), y

    (hr, hi), ys = lax.scan(step, (h0_re.astype(f32), h0_im.astype(f32)), uc)
    y = ys.transpose(1, 0, 2, 3, 4).reshape(bsz, L, D_MODEL) + d_skip.astype(f32) * uf
    y = jax.nn.gelu(y, approximate=False)
    a, g = jnp.split(y @ w_glu.astype(f32) + b_glu.astype(f32), 2, axis=-1)
    return (a * jax.nn.sigmoid(g)).astype(u.dtype), hr, hi


def window_attention(x, k_past, v_past, w_qkv, b_qkv, w_o, sinks, has_past):
    bsz, L, _ = x.shape
    f32 = jnp.float32
    W = WINDOW
    qkv = x @ w_qkv + b_qkv
    q, k, v = jnp.split(qkv, [N_HEADS * HEAD_DIM, (N_HEADS + N_KV_HEADS) * HEAD_DIM], axis=-1)
    q = q.reshape(bsz, L, N_KV_HEADS, GQA, HEAD_DIM)
    k = k.reshape(bsz, L, N_KV_HEADS, HEAD_DIM)
    v = v.reshape(bsz, L, N_KV_HEADS, HEAD_DIM)
    nb = -(-L // W)
    pad = nb * W - L
    qb = jnp.pad(q, ((0, 0), (0, pad), (0, 0), (0, 0), (0, 0))).reshape(
        bsz, nb, W, N_KV_HEADS, GQA, HEAD_DIM)

    def bands(t_past, t):
        t_all = jnp.concatenate(
            [t_past.astype(t.dtype), t, jnp.zeros((bsz, pad, N_KV_HEADS, HEAD_DIM), t.dtype)],
            axis=1).reshape(bsz, nb + 1, W, N_KV_HEADS, HEAD_DIM)
        return jnp.concatenate([t_all[:, :-1], t_all[:, 1:]], axis=2)

    kb, vb = bands(k_past, k), bands(v_past, v)
    s = jnp.einsum('bnikgd,bnjkd->bnkgij', qb.astype(f32), kb.astype(f32)) * (HEAD_DIM ** -0.5)
    i = jnp.arange(W)[:, None]
    j = jnp.arange(2 * W)[None, :]
    valid = jnp.broadcast_to((j >= i) & (j <= i + W), (nb, W, 2 * W))
    if not has_past:
        valid = valid & ((jnp.arange(nb)[:, None, None] * W + j[None]) >= W)
    s = jnp.where(valid[None, :, None, None], s, NEG)
    sink = sinks.astype(f32).reshape(N_KV_HEADS, GQA)[None, None, :, :, None, None]
    m = jnp.maximum(s.max(axis=-1, keepdims=True), sink)
    p = jnp.exp(s - m)
    p = p / (p.sum(axis=-1, keepdims=True) + jnp.exp(sink - m))
    o = jnp.einsum('bnkgij,bnjkd->bnikgd', p, vb.astype(f32)).reshape(
        bsz, nb * W, N_HEADS * HEAD_DIM)[:, :L]
    y = o.astype(x.dtype) @ w_o
    buf_k = jnp.concatenate([k_past.astype(k.dtype), k], axis=1)[:, -W:]
    buf_v = jnp.concatenate([v_past.astype(v.dtype), v], axis=1)[:, -W:]
    return y, buf_k, buf_v


def mem_kv(mem, g_mem, w_kv):
    k, v = jnp.split(rmsnorm(mem, g_mem) @ w_kv, 2, axis=-1)
    shp = (mem.shape[0], mem.shape[1], CA_HEADS, CA_HEAD_DIM)
    return k.reshape(shp), v.reshape(shp)


def cross_attention(x, mk, mv, w_q, w_o):
    bsz, L, _ = x.shape
    q = (x @ w_q).reshape(bsz, L, CA_HEADS, CA_HEAD_DIM)
    s = jnp.einsum('blhd,bmhd->bhlm', q.astype(jnp.float32), mk.astype(jnp.float32)) * (CA_HEAD_DIM ** -0.5)
    p = jax.nn.softmax(s, axis=-1)
    o = jnp.einsum('bhlm,bmhd->blhd', p, mv.astype(jnp.float32)).reshape(bsz, L, D_MODEL)
    return o.astype(x.dtype) @ w_o


def setup_inputs(seed: int = 0) -> dict:
    key = jax.random.key(seed)
    ks = iter(jax.random.split(key, 40))
    f32 = jnp.float32

    def nrm(shape, scale=1.0):
        return jax.random.normal(next(ks), shape, f32) * scale

    win = min(WINDOW, PAST_LEN)
    G, P, GS = SSM_GROUPS, SSM_STATE, SSM_GROUP
    return {
        "x_prompt": nrm((BATCH, SEQ, D_MODEL)),
        "x_sample": nrm((DEC_BATCH, DEC_SEQ, D_MODEL)),
        "mem_prompt": nrm((BATCH, N_MEM, D_MODEL)),
        "state_ssm_re": nrm((N_SSM_LAYERS, DEC_BATCH, G, P), 0.1),
        "state_ssm_im": nrm((N_SSM_LAYERS, DEC_BATCH, G, P), 0.1),
        "cache_win_k": nrm((N_SWA_LAYERS, DEC_BATCH, win, N_KV_HEADS, HEAD_DIM)),
        "cache_win_v": nrm((N_SWA_LAYERS, DEC_BATCH, win, N_KV_HEADS, HEAD_DIM)),
        "cache_mem_k": nrm((DEPTH, DEC_BATCH, N_MEM, CA_HEADS, CA_HEAD_DIM)),
        "cache_mem_v": nrm((DEPTH, DEC_BATCH, N_MEM, CA_HEADS, CA_HEAD_DIM)),
        "norm_g": 1.0 + nrm((DEPTH, 8, D_MODEL), 0.02),
        "mem_norm_g": 1.0 + nrm((DEPTH, D_MODEL), 0.02),
        "ffn_w_in": nrm((DEPTH, 2, D_MODEL, 2 * D_FF), D_MODEL ** -0.5),
        "ffn_w_out": nrm((DEPTH, 2, D_FF, D_MODEL), D_FF ** -0.5),
        "ssm_a_re": -0.5 + nrm((N_SSM_LAYERS, G, P), 0.01),
        "ssm_a_im": math.pi * jnp.arange(P, dtype=f32) + nrm((N_SSM_LAYERS, G, P), 0.01),
        "ssm_log_dt": jax.random.uniform(next(ks), (N_SSM_LAYERS, G), f32,
                                         math.log(DT_MIN), math.log(DT_MAX)),
        "ssm_b_re": nrm((N_SSM_LAYERS, G, P, GS), (2 * GS) ** -0.5),
        "ssm_b_im": nrm((N_SSM_LAYERS, G, P, GS), (2 * GS) ** -0.5),
        "ssm_c_re": nrm((N_SSM_LAYERS, G, GS, P), P ** -0.5),
        "ssm_c_im": nrm((N_SSM_LAYERS, G, GS, P), P ** -0.5),
        "ssm_d": nrm((N_SSM_LAYERS, D_MODEL)),
        "ssm_w_glu": nrm((N_SSM_LAYERS, D_MODEL, 2 * D_MODEL), D_MODEL ** -0.5),
        "ssm_b_glu": nrm((N_SSM_LAYERS, 2 * D_MODEL), 0.02),
        "attn_w_qkv": nrm((N_SWA_LAYERS, D_MODEL, QKV_WIDTH), D_MODEL ** -0.5),
        "attn_b_qkv": nrm((N_SWA_LAYERS, QKV_WIDTH), 0.02),
        "attn_w_o": nrm((N_SWA_LAYERS, N_HEADS * HEAD_DIM, D_MODEL), (N_HEADS * HEAD_DIM) ** -0.5),
        "attn_sinks": nrm((N_SWA_LAYERS, N_HEADS), 0.5),
        "ca_w_q": nrm((DEPTH, D_MODEL, D_MODEL), D_MODEL ** -0.5),
        "ca_w_kv": nrm((DEPTH, D_MODEL, 2 * D_MODEL), D_MODEL ** -0.5),
        "ca_w_o": nrm((DEPTH, D_MODEL, D_MODEL), D_MODEL ** -0.5),
    }


def reference(x_prompt, x_sample, mem_prompt, state_ssm_re, state_ssm_im, cache_win_k, cache_win_v,
              cache_mem_k, cache_mem_v, norm_g, mem_norm_g, ffn_w_in, ffn_w_out,
              ssm_a_re, ssm_a_im, ssm_log_dt, ssm_b_re, ssm_b_im, ssm_c_re, ssm_c_im, ssm_d,
              ssm_w_glu, ssm_b_glu, attn_w_qkv, attn_b_qkv, attn_w_o, attn_sinks,
              ca_w_q, ca_w_kv, ca_w_o):
    xp, xs = x_prompt, x_sample
    bp = xp.shape[0]
    ssm_re_p, ssm_im_p, ssm_re_s, ssm_im_s = [], [], [], []
    wk_p, wv_p, wk_s, wv_s = [], [], [], []
    mk_list, mv_list = [], []

    def half_ffn(x, i, j):
        g = norm_g[i]
        h = swiglu(rmsnorm(x, g[6 * j]), ffn_w_in[i, j], ffn_w_out[i, j])
        return x + FFN_RES * rmsnorm(h, g[6 * j + 1])

    for i in range(DEPTH):
        g = norm_g[i]
        xp = half_ffn(xp, i, 0)
        xs = half_ffn(xs, i, 0)
        li = i // N_MIXERS
        if i % N_MIXERS == 0:
            prm = (ssm_a_re[li], ssm_a_im[li], ssm_log_dt[li], ssm_b_re[li], ssm_b_im[li],
                   ssm_c_re[li], ssm_c_im[li], ssm_d[li], ssm_w_glu[li], ssm_b_glu[li])
            h0 = jnp.zeros((bp, SSM_GROUPS, SSM_STATE), jnp.float32)
            yp, hr_p, hi_p = s5_mixer(rmsnorm(xp, g[2]), h0, h0, *prm)
            ys, hr_s, hi_s = s5_mixer(rmsnorm(xs, g[2]), state_ssm_re[li], state_ssm_im[li], *prm)
            ssm_re_p.append(hr_p); ssm_im_p.append(hi_p)
            ssm_re_s.append(hr_s); ssm_im_s.append(hi_s)
        else:
            prm = (attn_w_qkv[li], attn_b_qkv[li], attn_w_o[li], attn_sinks[li])
            zpast = jnp.zeros((bp, WINDOW, N_KV_HEADS, HEAD_DIM), xp.dtype)
            yp, bk_p, bv_p = window_attention(rmsnorm(xp, g[2]), zpast, zpast, *prm, has_past=False)
            ys, bk_s, bv_s = window_attention(rmsnorm(xs, g[2]), cache_win_k[li], cache_win_v[li],
                                              *prm, has_past=True)
            wk_p.append(bk_p); wv_p.append(bv_p)
            wk_s.append(bk_s); wv_s.append(bv_s)
        xp = xp + rmsnorm(yp, g[3])
        xs = xs + rmsnorm(ys, g[3])
        mk, mv = mem_kv(mem_prompt, mem_norm_g[i], ca_w_kv[i])
        mk_list.append(mk); mv_list.append(mv)
        xp = xp + rmsnorm(cross_attention(rmsnorm(xp, g[4]), mk, mv, ca_w_q[i], ca_w_o[i]), g[5])
        xs = xs + rmsnorm(cross_attention(rmsnorm(xs, g[4]), cache_mem_k[i], cache_mem_v[i],
                                          ca_w_q[i], ca_w_o[i]), g[5])
        xp = half_ffn(xp, i, 1)
        xs = half_ffn(xs, i, 1)

    new_ssm_re_prompt = jnp.stack(ssm_re_p)
    new_ssm_im_prompt = jnp.stack(ssm_im_p)
    new_win_k_prompt = jnp.stack(wk_p)
    new_win_v_prompt = jnp.stack(wv_p)
    new_mem_k_prompt = jnp.stack(mk_list)
    new_mem_v_prompt = jnp.stack(mv_list)
    new_ssm_re_sample = jnp.stack(ssm_re_s)
    new_ssm_im_sample = jnp.stack(ssm_im_s)
    new_win_k_sample = jnp.stack(wk_s)
    new_win_v_sample = jnp.stack(wv_s)
    return (xp, xs, new_ssm_re_prompt, new_ssm_im_prompt, new_win_k_prompt, new_win_v_prompt,
            new_mem_k_prompt, new_mem_v_prompt, new_ssm_re_sample, new_ssm_im_sample,
            new_win_k_sample, new_win_v_sample)
```

```cpp
#include <hip/hip_runtime.h>
#include <hip/hip_bf16.h>
#include <cstdio>
#include <cstdint>
#include <cmath>
namespace pg8 {
#define PG8_LAS __attribute__((address_space(3)))
typedef unsigned short bf16_t;
typedef short bf16x8 __attribute__((ext_vector_type(8)));
typedef float f32x4 __attribute__((ext_vector_type(4)));
typedef float f32x2 __attribute__((ext_vector_type(2)));
typedef unsigned u32x4 __attribute__((ext_vector_type(4)));
typedef unsigned u32x2 __attribute__((ext_vector_type(2)));
constexpr int BM = 256, BK = 64, HALF = 128, HTB = HALF * BK * 2, STAGE_BYTES = 8 * HTB, NXCD = 8, WGM = 8;

__host__ __device__ __forceinline__ int lds_byte(int r, int c) { const int st = (r >> 4) * 2 + (c >> 5), rr = r & 15, cc = c & 31, ob = rr * 64 + cc * 2; return st * 1024 + (ob ^ (((ob >> 9) & 1) << 5)); }
__host__ __device__ __forceinline__ void stage_rc(int b, int& R, int& C) { const int st = b / 1024, sb = b % 1024, swz = sb ^ (((sb >> 9) & 1) << 5); R = (st >> 1) * 16 + swz / 64; C = (st & 1) * 32 + (swz % 64) / 2; }
__host__ __device__ __forceinline__ int perm32(int rho) { const int n = rho >> 4, i = rho & 15; return 8 * (i >> 2) + 4 * n + (i & 3); }

struct Unit { int pm, pn; };

struct StaticOrder {
    int nM, nN, nwg, G, c;
    __host__ __device__ void init(int nM_, int nN_, int G_, int c_) { nM = nM_; nN = nN_; nwg = nM * nN; G = G_; c = c_; }
    __host__ __device__ bool next(int i, Unit& u) const {
        const int L = i * G + c; if (L >= nwg) return false;
        int wgid = L; { const int q = nwg / NXCD, r = nwg % NXCD, xcd = wgid % NXCD, off = wgid / NXCD; wgid = (xcd < r ? xcd * (q + 1) : r * (q + 1) + (xcd - r) * q) + off; }
        const int nig = WGM * nN, gid = wgid / nig, fm = gid * WGM, gsz = (nM - fm) < WGM ? (nM - fm) : WGM;
        u.pm = fm + ((wgid % nig) % gsz); u.pn = (wgid % nig) / gsz; return true;
    }
    __device__ __forceinline__ void a_ready(const Unit&) const {}
    __device__ __forceinline__ void done(const Unit&) const {}
};

__device__ __forceinline__ unsigned cvt_pk_bf16(float lo, float hi) { unsigned r; asm volatile("v_cvt_pk_bf16_f32 %0, %1, %2" : "=v"(r) : "v"(lo), "v"(hi)); return r; }
__device__ __forceinline__ f32x2 gelu_pk(f32x2 v) {
    const f32x2 av = __builtin_elementwise_abs(v), d = av * 0.2316418882f + 1.0f;
    f32x2 t; t.x = __builtin_amdgcn_rcpf(d.x); t.y = __builtin_amdgcn_rcpf(d.y);
    f32x2 q = t * 0.5307027145f + (-0.7265760135f); q = q * t + 0.7107068705f; q = q * t + (-0.142248368f); q = q * t + 0.127414796f; q = q * t;
    const f32x2 s = (v * v) * (-0.72134752044f);
    f32x2 e; e.x = __builtin_amdgcn_exp2f(s.x); e.y = __builtin_amdgcn_exp2f(s.y);
    const f32x2 m = v * (q * e), r = v - m;
    f32x2 o; o.x = v.x < 0.f ? m.x : r.x; o.y = v.y < 0.f ? m.y : r.y; return o;
}
__device__ __forceinline__ float shflx(float v, int mask, int lane) { return __int_as_float(__builtin_amdgcn_ds_bpermute((lane ^ mask) << 2, __float_as_int(v))); }
__device__ __forceinline__ float sigmoid_f(float x) { return __builtin_amdgcn_rcpf(1.0f + __builtin_amdgcn_exp2f(-1.4426950408889634f * x)); }

template <class GD, class Epi, class Sched, bool ALIGN_EPI>
__device__ __forceinline__ void gemm_phase(PG8_LAS unsigned char* lds, const GD g, const Sched& S, const Epi& E) {
    int tid = threadIdx.x; asm volatile("" : "+v"(tid));
    const int wid = __builtin_amdgcn_readfirstlane(tid >> 6), lane = tid & 63, wr = wid >> 2, wc = wid & 3, fr = lane & 15, fq = lane >> 4;
    constexpr int nt = GD::NT;
    unsigned voffA[2], voffB[2];
#pragma unroll
    for (int i = 0; i < 2; ++i) { int R, C; stage_rc(tid * 16 + i * 8192, R, C); const int Rb = Epi::PERM ? ((R & ~31) + perm32(R & 31)) : R;
        voffA[i] = (GD::AMODE == 1) ? (unsigned)(R * GD::LDA + (C >> 4) * 1024 + (C & 15)) * 2u : (unsigned)(R * GD::LDA + C) * 2u;
        voffB[i] = (unsigned)(Rb * GD::LDB + C) * 2u; }
    constexpr unsigned kstepA = GD::KSTEPA, kstepB = GD::KSTEPB;
    constexpr unsigned hstepA = HALF * GD::LDA * 2, hstepB = HALF * GD::LDB * 2;
    const unsigned ldsw = (unsigned)wid * 1024u;
    const int aoff = lds_byte(wr * 64 + fr, fq * 8), boff = lds_byte(wc * 32 + fr, fq * 8);
#define PG8_SA(b, h) (((b) * 2 + (h)) * HTB)
#define PG8_SB(b, h) ((4 + (b) * 2 + (h)) * HTB)
#define PG8_STAGE(bufoff, gbase, voff) do { _Pragma("unroll") for (int _i = 0; _i < 2; ++_i) \
        __builtin_amdgcn_global_load_lds((const unsigned*)((const char*)(gbase) + (voff)[_i]), (PG8_LAS unsigned*)(lds + (bufoff) + ldsw + _i * 8192), 16, 0, 0); } while (0)
#define PG8_LDA(dst, b, h) do { _Pragma("unroll") for (int m = 0; m < 4; ++m) _Pragma("unroll") for (int k = 0; k < 2; ++k) dst[m][k] = *(const PG8_LAS bf16x8*)(lds + PG8_SA(b, h) + aoff + m * 2048 + k * 1024); } while (0)
#define PG8_LDB(dst, b, h) do { _Pragma("unroll") for (int n = 0; n < 2; ++n) _Pragma("unroll") for (int k = 0; k < 2; ++k) dst[n][k] = *(const PG8_LAS bf16x8*)(lds + PG8_SB(b, h) + boff + n * 2048 + k * 1024); } while (0)
#define PG8_MMA(ai, bj, At, Bt) do { __builtin_amdgcn_s_setprio(1); _Pragma("unroll") for (int m = 0; m < 4; ++m) _Pragma("unroll") for (int n = 0; n < 2; ++n) _Pragma("unroll") for (int k = 0; k < 2; ++k) \
        acc[ai][bj][m][n] = __builtin_amdgcn_mfma_f32_16x16x32_bf16(Bt[n][k], At[m][k], acc[ai][bj][m][n], 0, 0, 0); __builtin_amdgcn_s_setprio(0); } while (0)
#define PG8_WAIT_V(n) asm volatile("s_waitcnt vmcnt(" #n ")" ::: "memory")
#define PG8_WAIT_L(n) asm volatile("s_waitcnt lgkmcnt(" #n ")" ::: "memory")
#define PG8_BAR __builtin_amdgcn_s_barrier()
#define PG8_SCHED __builtin_amdgcn_sched_barrier(0)
    Unit cur, nxt; int ui = 0;
    if (!S.next(0, cur)) return;
    f32x4 acc[2][2][4][2];
#pragma unroll
    for (int a = 0; a < 2; ++a)
#pragma unroll
        for (int b = 0; b < 2; ++b)
#pragma unroll
            for (int m = 0; m < 4; ++m)
#pragma unroll
                for (int n = 0; n < 2; ++n) acc[a][b][m][n] = (f32x4){0.f, 0.f, 0.f, 0.f};
    bf16x8 At[4][2], B0[2][2], B1[2][2];
    const char* cA = g.aptr(cur); const char* cB = g.bptr(cur);
    S.a_ready(cur);
    PG8_STAGE(PG8_SB(0, 0), cB, voffB); PG8_STAGE(PG8_SB(0, 1), cB + hstepB, voffB); PG8_STAGE(PG8_SA(0, 0), cA, voffA); PG8_STAGE(PG8_SA(0, 1), cA + hstepA, voffA);
    if (wr == 1) PG8_BAR;
    PG8_WAIT_V(2); PG8_BAR;
    PG8_STAGE(PG8_SB(1, 0), cB + kstepB, voffB); PG8_STAGE(PG8_SA(1, 0), cA + kstepA, voffA); PG8_STAGE(PG8_SB(1, 1), cB + hstepB + kstepB, voffB);
    PG8_WAIT_V(6); PG8_BAR;
    for (;;) {
        const bool has_next = S.next(ui + 1, nxt);
        const char* nA = has_next ? g.aptr(nxt) : cA; const char* nB = has_next ? g.bptr(nxt) : cB;
        for (int t = 0; t < nt; t += 2) {
            const bool last = (t == nt - 2);
            const char* a1 = cA + (unsigned)(t + 1) * kstepA;
            const char* a2 = last ? nA : cA + (unsigned)(t + 2) * kstepA; const char* b2 = last ? nB : cB + (unsigned)(t + 2) * kstepB;
            const char* a3 = a2 + kstepA; const char* b3 = b2 + kstepB;
            if (last && has_next) S.a_ready(nxt);
            PG8_LDB(B0, 0, 0); PG8_LDB(B1, 0, 1); PG8_SCHED; PG8_LDA(At, 0, 0); PG8_STAGE(PG8_SA(1, 1), a1 + hstepA, voffA);
            PG8_WAIT_V(8); PG8_WAIT_L(0); PG8_BAR; PG8_MMA(0, 0, At, B0); PG8_MMA(0, 1, At, B1); PG8_BAR; PG8_SCHED;
            PG8_LDA(At, 0, 1); PG8_STAGE(PG8_SB(0, 0), b2, voffB); PG8_STAGE(PG8_SB(0, 1), b2 + hstepB, voffB); PG8_STAGE(PG8_SA(0, 0), a2, voffA);
            PG8_WAIT_V(8); PG8_WAIT_L(0); PG8_BAR; PG8_MMA(1, 0, At, B0); PG8_MMA(1, 1, At, B1); PG8_BAR; PG8_SCHED;
            PG8_LDB(B0, 1, 0); PG8_LDB(B1, 1, 1); PG8_SCHED; PG8_LDA(At, 1, 0); PG8_STAGE(PG8_SA(0, 1), a2 + hstepA, voffA);
            PG8_WAIT_V(8); PG8_WAIT_L(0); PG8_BAR; PG8_MMA(0, 0, At, B0); PG8_MMA(0, 1, At, B1); PG8_BAR; PG8_SCHED;
            PG8_LDA(At, 1, 1); PG8_STAGE(PG8_SB(1, 0), b3, voffB); PG8_STAGE(PG8_SB(1, 1), b3 + hstepB, voffB); PG8_STAGE(PG8_SA(1, 0), a3, voffA);
            PG8_WAIT_V(8); PG8_WAIT_L(0); PG8_BAR; PG8_MMA(1, 0, At, B0); PG8_MMA(1, 1, At, B1); PG8_BAR; PG8_SCHED;
        }
        if constexpr (ALIGN_EPI) { if (wr == 0) PG8_BAR; }
        if constexpr (!Epi::AFTER_DRAIN) { E(acc, cur, wr, wc, fr, fq); S.done(cur); }
        if (!has_next) break;
#pragma unroll
        for (int a = 0; a < 2; ++a)
#pragma unroll
            for (int b = 0; b < 2; ++b)
#pragma unroll
                for (int m = 0; m < 4; ++m)
#pragma unroll
                    for (int n = 0; n < 2; ++n) acc[a][b][m][n] = (f32x4){0.f, 0.f, 0.f, 0.f};
        cur = nxt; cA = nA; cB = nB; ++ui;
        if constexpr (ALIGN_EPI) { if (wr == 1) PG8_BAR; }
    }
    PG8_WAIT_V(0);
    if constexpr (!ALIGN_EPI) { if (wr == 0) PG8_BAR; }
    PG8_BAR;
    if constexpr (Epi::AFTER_DRAIN) { E.fused(acc, cur, wr, wc, fr, fq, lds, wid, lane); S.done(cur); }
#undef PG8_SA
#undef PG8_SB
#undef PG8_STAGE
#undef PG8_LDA
#undef PG8_LDB
#undef PG8_MMA
#undef PG8_WAIT_V
#undef PG8_WAIT_L
#undef PG8_BAR
#undef PG8_SCHED
}
}
namespace pg8 {
#define EPI_ARGS const f32x4 (&acc)[2][2][4][2], const Unit& u, int wr, int wc, int fr, int fq
struct EpiF32 {
    static constexpr bool PERM = false, AFTER_DRAIN = false;
    float* C; int ldc; const float* bias;
    __device__ __forceinline__ void operator()(EPI_ARGS) const {
        const int row0 = u.pm * BM + wr * 64 + fr, col0 = u.pn * BM + wc * 32 + 4 * fq;
        f32x4 bv[2][2];
#pragma unroll
        for (int bj = 0; bj < 2; ++bj)
#pragma unroll
            for (int n = 0; n < 2; ++n) bv[bj][n] = bias ? *(const f32x4*)(bias + col0 + bj * HALF + n * 16) : (f32x4){0.f, 0.f, 0.f, 0.f};
#pragma unroll
        for (int ai = 0; ai < 2; ++ai)
#pragma unroll
            for (int m = 0; m < 4; ++m) { float* rowp = C + (size_t)(row0 + ai * HALF + m * 16) * ldc + col0;
#pragma unroll
                for (int bj = 0; bj < 2; ++bj)
#pragma unroll
                    for (int n = 0; n < 2; ++n) *(f32x4*)(rowp + bj * HALF + n * 16) = acc[ai][bj][m][n] + bv[bj][n]; }
    }
};
struct EpiMemKV {
    static constexpr bool PERM = false, AFTER_DRAIN = false;
    float* outK; float* outV;
    __device__ __forceinline__ void operator()(EPI_ARGS) const {
        const int l = u.pm >> 1, rp = u.pm & 1; float* base = ((u.pn < 4) ? outK : outV) + (size_t)l * 512 * 1024;
        const int row0 = rp * BM + wr * 64 + fr, col0 = (u.pn & 3) * BM + wc * 32 + 4 * fq;
#pragma unroll
        for (int ai = 0; ai < 2; ++ai)
#pragma unroll
            for (int m = 0; m < 4; ++m) { float* rowp = base + (size_t)(row0 + ai * HALF + m * 16) * 1024 + col0;
#pragma unroll
                for (int bj = 0; bj < 2; ++bj)
#pragma unroll
                    for (int n = 0; n < 2; ++n) *(f32x4*)(rowp + bj * HALF + n * 16) = acc[ai][bj][m][n]; }
    }
};
struct EpiSwiGLU {
    static constexpr bool PERM = true, AFTER_DRAIN = false;
    bf16_t* H; int ldh;
    __device__ __forceinline__ void operator()(EPI_ARGS) const {
        const int row0 = u.pm * BM + wr * 64 + fr, col0 = u.pn * HALF + wc * 32 + 8 * fq;
#pragma unroll
        for (int ai = 0; ai < 2; ++ai)
#pragma unroll
            for (int m = 0; m < 4; ++m) { bf16_t* rowp = H + (size_t)(row0 + ai * HALF + m * 16) * ldh + col0;
                float h[8];
#pragma unroll
                for (int n = 0; n < 2; ++n)
#pragma unroll
                    for (int e = 0; e < 4; ++e) { const float gt = acc[ai][0][m][n][e], up = acc[ai][1][m][n][e]; h[n * 4 + e] = gt * sigmoid_f(gt) * up; }
                u32x4 w; w.x = cvt_pk_bf16(h[0], h[1]); w.y = cvt_pk_bf16(h[2], h[3]); w.z = cvt_pk_bf16(h[4], h[5]); w.w = cvt_pk_bf16(h[6], h[7]);
                *(u32x4*)rowp = w; }
    }
};
struct EpiGLU {
    static constexpr bool PERM = false, AFTER_DRAIN = false;
    float* Y; const float* bias;
    __device__ __forceinline__ void operator()(EPI_ARGS) const {
        const int row0 = u.pm * BM + wr * 64 + fr, col0 = u.pn * HALF + wc * 32 + 4 * fq;
        f32x4 ba[2], bg[2];
#pragma unroll
        for (int n = 0; n < 2; ++n) { ba[n] = *(const f32x4*)(bias + col0 + n * 16); bg[n] = *(const f32x4*)(bias + 1024 + col0 + n * 16); }
#pragma unroll
        for (int ai = 0; ai < 2; ++ai)
#pragma unroll
            for (int m = 0; m < 4; ++m) { float* rowp = Y + (size_t)(row0 + ai * HALF + m * 16) * 1024 + col0;
#pragma unroll
                for (int n = 0; n < 2; ++n) { const f32x4 a = acc[ai][0][m][n] + ba[n], gg = acc[ai][1][m][n] + bg[n]; f32x4 o;
#pragma unroll
                    for (int e = 0; e < 4; ++e) o[e] = a[e] * sigmoid_f(gg[e]);
                    *(f32x4*)(rowp + n * 16) = o; } }
    }
};
struct EpiBf16 {
    static constexpr bool PERM = true, AFTER_DRAIN = false;
    bf16_t* O; int ldc;
    __device__ __forceinline__ void operator()(EPI_ARGS) const {
        const int row0 = u.pm * BM + wr * 64 + fr, col0 = u.pn * BM + wc * 32 + 8 * fq;
#pragma unroll
        for (int ai = 0; ai < 2; ++ai)
#pragma unroll
            for (int m = 0; m < 4; ++m) { bf16_t* rowp = O + (size_t)(row0 + ai * HALF + m * 16) * ldc + col0;
#pragma unroll
                for (int bj = 0; bj < 2; ++bj) { const f32x4 v0 = acc[ai][bj][m][0], v1 = acc[ai][bj][m][1];
                    u32x4 w; w.x = cvt_pk_bf16(v0[0], v0[1]); w.y = cvt_pk_bf16(v0[2], v0[3]); w.z = cvt_pk_bf16(v1[0], v1[1]); w.w = cvt_pk_bf16(v1[2], v1[3]);
                    *(u32x4*)(rowp + bj * HALF) = w; } }
    }
};
struct EpiQKV {
    static constexpr bool PERM = true, AFTER_DRAIN = false;
    bf16_t* Q; bf16_t* K; bf16_t* V; const float* bias; float qscale;
    __device__ __forceinline__ void operator()(EPI_ARGS) const {
        bf16_t* base; int ldc, colt; float sc = 1.f;
        if (u.pn < 4) { base = Q; ldc = 1024; colt = u.pn * BM; sc = qscale; } else if (u.pn == 4) { base = K; ldc = 256; colt = 0; } else { base = V; ldc = 256; colt = 0; }
        const int row0 = u.pm * BM + wr * 64 + fr, col0 = colt + wc * 32 + 8 * fq, bcol0 = u.pn * BM + wc * 32 + 8 * fq;
        f32x4 bv[2][2];
#pragma unroll
        for (int bj = 0; bj < 2; ++bj)
#pragma unroll
            for (int n = 0; n < 2; ++n) bv[bj][n] = *(const f32x4*)(bias + bcol0 + bj * HALF + 4 * n);
#pragma unroll
        for (int ai = 0; ai < 2; ++ai)
#pragma unroll
            for (int m = 0; m < 4; ++m) { bf16_t* rowp = base + (size_t)(row0 + ai * HALF + m * 16) * ldc + col0;
#pragma unroll
                for (int bj = 0; bj < 2; ++bj) { const f32x4 v0 = (acc[ai][bj][m][0] + bv[bj][0]) * sc, v1 = (acc[ai][bj][m][1] + bv[bj][1]) * sc;
                    u32x4 w; w.x = cvt_pk_bf16(v0[0], v0[1]); w.y = cvt_pk_bf16(v0[2], v0[3]); w.z = cvt_pk_bf16(v1[0], v1[1]); w.w = cvt_pk_bf16(v1[2], v1[3]);
                    *(u32x4*)(rowp + bj * HALF) = w; } }
    }
};
struct EpiSoftmaxP {
    static constexpr bool PERM = true, AFTER_DRAIN = true;
    bf16_t* P;
    __device__ __forceinline__ void fused(f32x4 (&acc)[2][2][4][2], const Unit& u, int wr, int wc, int fr, int fq, PG8_LAS unsigned char* lds, int wid, int lane) const {
        PG8_LAS f32x2* X = (PG8_LAS f32x2*)lds;
        const float SC = 0.0625f * 1.4426950408889634f;
        float mloc[2][4];
#pragma unroll
        for (int ai = 0; ai < 2; ++ai)
#pragma unroll
            for (int m = 0; m < 4; ++m) {
                float mx = -3.0e38f;
#pragma unroll
                for (int bj = 0; bj < 2; ++bj)
#pragma unroll
                    for (int n = 0; n < 2; ++n) { acc[ai][bj][m][n] = acc[ai][bj][m][n] * SC; const f32x4 x = acc[ai][bj][m][n]; mx = fmaxf(mx, fmaxf(fmaxf(x[0], x[1]), fmaxf(x[2], x[3]))); }
                mx = fmaxf(mx, shflx(mx, 16, fq * 16 + fr)); mx = fmaxf(mx, shflx(mx, 32, fq * 16 + fr));
                float s = 0.f;
#pragma unroll
                for (int bj = 0; bj < 2; ++bj)
#pragma unroll
                    for (int n = 0; n < 2; ++n) { const f32x4 x = acc[ai][bj][m][n]; s += (__builtin_amdgcn_exp2f(x[0] - mx) + __builtin_amdgcn_exp2f(x[1] - mx)) + (__builtin_amdgcn_exp2f(x[2] - mx) + __builtin_amdgcn_exp2f(x[3] - mx)); }
                s += shflx(s, 16, fq * 16 + fr); s += shflx(s, 32, fq * 16 + fr);
                mloc[ai][m] = mx;
                if (fq == 0) X[(ai * HALF + wr * 64 + m * 16 + fr) * 4 + wc] = (f32x2){mx, s};
            }
        asm volatile("s_waitcnt lgkmcnt(0)" ::: "memory"); __builtin_amdgcn_s_barrier(); asm volatile("" ::: "memory");
        const int row0 = u.pm * BM + wr * 64 + fr, col0 = u.pn * BM + wc * 32 + 8 * fq;
#pragma unroll
        for (int ai = 0; ai < 2; ++ai)
#pragma unroll
            for (int m = 0; m < 4; ++m) {
                const int r = ai * HALF + wr * 64 + m * 16 + fr;
                const f32x2 a = X[r * 4 + 0], b = X[r * 4 + 1], c = X[r * 4 + 2], d = X[r * 4 + 3];
                const float M = fmaxf(fmaxf(a.x, b.x), fmaxf(c.x, d.x));
                const float S = a.y * __builtin_amdgcn_exp2f(a.x - M) + b.y * __builtin_amdgcn_exp2f(b.x - M) + c.y * __builtin_amdgcn_exp2f(c.x - M) + d.y * __builtin_amdgcn_exp2f(d.x - M);
                const float inv = 1.0f / S;
                bf16_t* rowp = P + (size_t)(row0 + ai * HALF + m * 16) * 1024 + col0;
#pragma unroll
                for (int bj = 0; bj < 2; ++bj) { f32x4 v0 = acc[ai][bj][m][0], v1 = acc[ai][bj][m][1];
#pragma unroll
                    for (int e = 0; e < 4; ++e) { v0[e] = __builtin_amdgcn_exp2f(v0[e] - M) * inv; v1[e] = __builtin_amdgcn_exp2f(v1[e] - M) * inv; }
                    u32x4 w; w.x = cvt_pk_bf16(v0[0], v0[1]); w.y = cvt_pk_bf16(v0[2], v0[3]); w.z = cvt_pk_bf16(v1[0], v1[1]); w.w = cvt_pk_bf16(v1[2], v1[3]);
                    *(u32x4*)(rowp + bj * HALF) = w; }
            }
        (void)mloc; (void)wid; (void)lane;
    }
};
struct EpiSsmA {
    static constexpr bool PERM = false, AFTER_DRAIN = false;
    float* SL;
    __device__ __forceinline__ void operator()(EPI_ARGS) const {
        const int row0 = u.pm * BM + wr * 64 + fr, col0 = u.pn * HALF + wc * 32 + 4 * fq;
#pragma unroll
        for (int ai = 0; ai < 2; ++ai)
#pragma unroll
            for (int m = 0; m < 4; ++m) { float* rowp = SL + (size_t)(row0 + ai * HALF + m * 16) * 8192 + col0;
#pragma unroll
                for (int n = 0; n < 2; ++n) *(f32x4*)(rowp + n * 16) = acc[ai][0][m][n]; }
    }
};
struct EpiSsmB {
    static constexpr bool PERM = true, AFTER_DRAIN = false;
    bf16_t* Gout; const bf16_t* XP; const float* dskip;
    __device__ __forceinline__ void operator()(EPI_ARGS) const {
        const int g = u.pn >> 1, half = u.pn & 1;
        const int ch0 = g * 16 + 8 * (fq & 1);
        const f32x4 d0 = *(const f32x4*)(dskip + ch0), d1 = *(const f32x4*)(dskip + ch0 + 4);
#pragma unroll
        for (int ai = 0; ai < 2; ++ai)
#pragma unroll
            for (int m = 0; m < 4; ++m) { const int chunk = u.pm * BM + ai * HALF + wr * 64 + m * 16 + fr;
#pragma unroll
                for (int bj = 0; bj < 2; ++bj) { const int t = 16 * half + 8 * bj + 2 * wc + (fq >> 1);
                    const u32x4 uw = *(const u32x4*)(XP + ((size_t)chunk * 40 + t) * 1024 + ch0);
                    f32x4 v0 = acc[ai][bj][m][0], v1 = acc[ai][bj][m][1];
                    v0[0] += d0[0] * __uint_as_float(uw.x << 16); v0[1] += d0[1] * __uint_as_float(uw.x & 0xffff0000u);
                    v0[2] += d0[2] * __uint_as_float(uw.y << 16); v0[3] += d0[3] * __uint_as_float(uw.y & 0xffff0000u);
                    v1[0] += d1[0] * __uint_as_float(uw.z << 16); v1[1] += d1[1] * __uint_as_float(uw.z & 0xffff0000u);
                    v1[2] += d1[2] * __uint_as_float(uw.w << 16); v1[3] += d1[3] * __uint_as_float(uw.w & 0xffff0000u);
                    const f32x2 a = gelu_pk((f32x2){v0[0], v0[1]}), b = gelu_pk((f32x2){v0[2], v0[3]}), c = gelu_pk((f32x2){v1[0], v1[1]}), d = gelu_pk((f32x2){v1[2], v1[3]});
                    u32x4 w; w.x = cvt_pk_bf16(a.x, a.y); w.y = cvt_pk_bf16(b.x, b.y); w.z = cvt_pk_bf16(c.x, c.y); w.w = cvt_pk_bf16(d.x, d.y);
                    *(u32x4*)(Gout + ((size_t)chunk * 32 + t) * 1024 + ch0) = w; } }
    }
};
#undef EPI_ARGS
}
namespace swa_body {
using bf16=__hip_bfloat16;
using bf16x8=__attribute__((ext_vector_type(8)))short;
using s16x4=__attribute__((ext_vector_type(4)))short;
using f32x16=__attribute__((ext_vector_type(16)))float;
using u32x4=__attribute__((ext_vector_type(4)))unsigned;
constexpr int BATCH=2,NHEAD=16,SEQ=8192,D=64,QP=1024,KVP=256;
constexpr int NW=8,QBLK=32,QB=QBLK*NW,KVBLK=64,NQB=SEQ/QB;
constexpr int ATTN_UNIT_ROWS=QB;
__device__ __forceinline__ int crow(int r,int hi){return (r&3)+8*(r>>2)+4*hi;}
#define SBAR() __builtin_amdgcn_sched_barrier(0)
__device__ __forceinline__ void wmask(f32x16&p0,f32x16&p1,int t,int qrel,int hi,int coff){
  const float NEG=-INFINITY; const int kb=64*t-coff+4*hi;
  #pragma unroll
  for(int r=0;r<16;++r){const int kr=kb+(r&3)+8*(r>>2); if(kr>qrel||kr<qrel-128)p0[r]=NEG; if(kr+32>qrel||kr+32<qrel-128)p1[r]=NEG;}
}
constexpr int NSLOT=3, SLOTB=8192;
constexpr int LDS_K=0, LDS_V=NSLOT*SLOTB, LDS_WS=2*NSLOT*SLOTB, LDS_OST=LDS_WS+NW*64*4, LDS_BYTES=LDS_OST+NW*4096;
constexpr float C2=0.125f*1.4426950408889634f;
__device__ __forceinline__ void glds16(const void*gsrc,unsigned lds_dst){unsigned keep;
  asm volatile("s_mov_b32 %0, m0\n\ts_mov_b32 m0, %2\n\ts_nop 0\n\tglobal_load_lds_dwordx4 %1, off\n\ts_mov_b32 m0, %0":"=&s"(keep):"v"(gsrc),"s"(lds_dst):"memory");}
__device__ __forceinline__ float max3f(float a,float b,float c){float r;asm("v_max3_f32 %0, %1, %2, %3":"=v"(r):"v"(a),"v"(b),"v"(c));return r;}
__device__ __forceinline__ float max2f(float a,float b){float r;asm("v_max_f32_e32 %0, %1, %2":"=v"(r):"v"(a),"v"(b));return r;}
__device__ __forceinline__ float fadd_s(float a,float b){float r;asm("v_add_f32_e32 %0, %1, %2":"=v"(r):"v"(a),"v"(b));return r;}
__device__ __forceinline__ float fsub_s(float a,float b){float r;asm("v_sub_f32_e32 %0, %1, %2":"=v"(r):"v"(a),"v"(b));return r;}
typedef float f32x2_t __attribute__((ext_vector_type(2))); typedef __bf16 bf16x2_t __attribute__((ext_vector_type(2)));
__device__ __forceinline__ unsigned cvtpk_s(float lo,float hi){f32x2_t v={lo,hi};bf16x2_t b=__builtin_convertvector(v,bf16x2_t);return __builtin_bit_cast(unsigned,b);}
#define WAIT_BAR(N) asm volatile("s_waitcnt vmcnt(" #N ") lgkmcnt(0)\n\ts_barrier":::"memory")

__device__ __forceinline__ void qkt(f32x16&p0,f32x16&p1,const char*Kslot,const bf16x8*qr,const f32x16&negm,int r32,int hi){
  const char*kb=Kslot+hi*1024+r32*16;
  #pragma unroll
  for(int d0=0;d0<4;++d0){
    const bf16x8 b0=*reinterpret_cast<const bf16x8*>(kb+d0*2048);
    const bf16x8 b1=*reinterpret_cast<const bf16x8*>(kb+d0*2048+512);
    if(d0==0){p0=__builtin_amdgcn_mfma_f32_32x32x16_bf16(b0,qr[0],negm,0,0,0);p1=__builtin_amdgcn_mfma_f32_32x32x16_bf16(b1,qr[0],negm,0,0,0);}
    else{p0=__builtin_amdgcn_mfma_f32_32x32x16_bf16(b0,qr[d0],p0,0,0,0);p1=__builtin_amdgcn_mfma_f32_32x32x16_bf16(b1,qr[d0],p1,0,0,0);}}
}
typedef __attribute__((address_space(3))) const char* lds_cptr;
typedef short v4i16_t __attribute__((ext_vector_type(4)));
__device__ __forceinline__ void kload8(bf16x8*kf,lds_cptr kp){
  kf[0]=*(const __attribute__((address_space(3))) bf16x8*)(kp);      kf[1]=*(const __attribute__((address_space(3))) bf16x8*)(kp+512);
  kf[2]=*(const __attribute__((address_space(3))) bf16x8*)(kp+2048); kf[3]=*(const __attribute__((address_space(3))) bf16x8*)(kp+2560);
  kf[4]=*(const __attribute__((address_space(3))) bf16x8*)(kp+4096); kf[5]=*(const __attribute__((address_space(3))) bf16x8*)(kp+4608);
  kf[6]=*(const __attribute__((address_space(3))) bf16x8*)(kp+6144); kf[7]=*(const __attribute__((address_space(3))) bf16x8*)(kp+6656);
}
__device__ __forceinline__ void kload2(bf16x8*kf,lds_cptr kp,int j){ kf[2*j]=*(const __attribute__((address_space(3))) bf16x8*)(kp+j*2048); kf[2*j+1]=*(const __attribute__((address_space(3))) bf16x8*)(kp+j*2048+512); }
__device__ __forceinline__ s16x4 vtr(lds_cptr p){ return __builtin_bit_cast(s16x4,__builtin_amdgcn_ds_read_tr16_b64_v4i16((__attribute__((address_space(3))) v4i16_t*)p)); }
__device__ __forceinline__ float rowmax(const f32x16&p0,const f32x16&p1){
  float a=max3f(p0[0],p0[1],p1[0]),b=max3f(p0[2],p0[3],p1[1]);a=max3f(a,p1[2],p1[3]);
  #pragma unroll
  for(int r=4;r<16;r+=4){a=max3f(a,p0[r],p0[r+1]);b=max3f(b,p0[r+2],p0[r+3]);a=max3f(a,p1[r],p1[r+1]);b=max3f(b,p1[r+2],p1[r+3]);}
  const float m=max2f(a,b);
  auto rr=__builtin_amdgcn_permlane32_swap(__float_as_uint(m),__float_as_uint(m),false,false);
  return max2f(__uint_as_float(rr[0]),__uint_as_float(rr[1]));
}
__device__ __forceinline__ void pv(f32x16*o,int vb,bf16x8 pa0,bf16x8 pa1,bf16x8 pa2,bf16x8 pa3){
  #pragma unroll
  for(int d0=0;d0<2;++d0){s16x4 lo[4],hi[4];
    #pragma unroll
    for(int ks=0;ks<4;++ks){
      asm volatile("ds_read_b64_tr_b16 %0,%1 offset:%c2":"=&v"(lo[ks]):"v"(vb),"i"(d0*4096+ks*1024):"memory");
      asm volatile("ds_read_b64_tr_b16 %0,%1 offset:%c2":"=&v"(hi[ks]):"v"(vb),"i"(d0*4096+ks*1024+512):"memory");}
    asm volatile("s_waitcnt lgkmcnt(0)":::"memory");SBAR();
    #define PK(k) (bf16x8){lo[k][0],lo[k][1],lo[k][2],lo[k][3],hi[k][0],hi[k][1],hi[k][2],hi[k][3]}
    o[d0]=__builtin_amdgcn_mfma_f32_32x32x16_bf16(pa0,PK(0),o[d0],0,0,0);
    o[d0]=__builtin_amdgcn_mfma_f32_32x32x16_bf16(pa1,PK(1),o[d0],0,0,0);
    o[d0]=__builtin_amdgcn_mfma_f32_32x32x16_bf16(pa2,PK(2),o[d0],0,0,0);
    o[d0]=__builtin_amdgcn_mfma_f32_32x32x16_bf16(pa3,PK(3),o[d0],0,0,0);
    #undef PK
  }
}

#ifndef ATTN_STORE16
#define ATTN_STORE16(p,v) (*(u32x4*)(p)=(v))
#endif
template<int THRL> __device__ __forceinline__ void attn_unit(int b,int h,int qb,const bf16*Q,const bf16*__restrict__ K,const bf16*__restrict__ V,bf16*O,char*shm,float sink2){
  int tid=threadIdx.x; asm volatile("":"+v"(tid)); const int lane=tid&63,r32=lane&31,hi=lane>>5; const int wid=__builtin_amdgcn_readfirstlane(tid>>6);
  const long rowbase=(long)b*SEQ; const int q0=qb*QB;
  const int t_start=(qb>0)?4*qb-2:0, coff=q0-64*t_start;
  const bf16*Qw=Q+(rowbase+q0+wid*QBLK)*QP+h*D;
  const bf16*Kh=K+(rowbase+64*t_start)*KVP+(h>>2)*D,*Vh=V+(rowbase+64*t_start)*KVP+(h>>2)*D;
  const unsigned lds0=(unsigned)(uintptr_t)shm;
  float*wsf=(float*)(shm+LDS_WS)+wid*64;
  const bf16*ksrc=Kh+(long)lane*KVP+wid*8;
  const bf16*vsrc=Vh+(long)(16*(wid&3)+(lane>>2))*KVP+(wid>>2)*32+(lane&3)*8;
  const unsigned kdst=lds0+LDS_K+wid*1024, vdst=lds0+LDS_V+wid*1024;
  #define DMA_K(t,slot) glds16(ksrc+(long)(t)*KVBLK*KVP,(unsigned)__builtin_amdgcn_readfirstlane(kdst+(slot)))
  #define DMA_V(t,slot) glds16(vsrc+(long)(t)*KVBLK*KVP,(unsigned)__builtin_amdgcn_readfirstlane(vdst+(slot)))
  const int vb0=(int)(lds0+LDS_V)+((lane>>4)&1)*32+(lane&3)*8+(4*hi+((lane&15)>>2))*64;
  const char*Kbase=shm+LDS_K; bf16x8 kf[8];
  const lds_cptr shm3=(lds_cptr)shm; const lds_cptr kp0=shm3+LDS_K+hi*1024+r32*16; const lds_cptr vp0=shm3+LDS_V+((lane>>4)&1)*32+(lane&3)*8+(4*hi+((lane&15)>>2))*64;
  const int NT=(q0+QB)/KVBLK-t_start;
  DMA_K(0,0);DMA_V(0,0);DMA_K(1,SLOTB);
  bf16x8 qr[4];
  #pragma unroll
  for(int d0=0;d0<4;++d0)qr[d0]=*reinterpret_cast<const bf16x8*>(&Qw[(long)r32*QP+d0*16+hi*8]);
  float mhat=0.f,l_reg=0.f;f32x16 o[2];o[0]=f32x16{};o[1]=f32x16{};f32x16 negm=f32x16{};asm volatile("":"+v"(negm));
  const int qrel=wid*QBLK+r32;
  #define CMASK(P0,P1,t) wmask(P0,P1,(t),qrel,hi,coff)
  bool resc=false;
  #define START(P0,P1) do{ const float rm=rowmax(P0,P1); resc=false; \
    { const float dl=max2f(rm,sink2); mhat=fadd_s(mhat,dl); l_reg=(hi==0)?__builtin_amdgcn_exp2f(sink2-dl):0.f; \
      _Pragma("unroll") for(int r=0;r<16;++r){P0[r]=fsub_s(P0[r],dl);P1[r]=fsub_s(P1[r],dl);} \
      _Pragma("unroll") for(int r=0;r<16;++r)negm[r]=-mhat; asm volatile("":"+v"(negm)); } \
    _Pragma("unroll") for(int r=0;r<16;++r)P0[r]=__builtin_amdgcn_exp2f(P0[r]); }while(0)
  #define RESC() do{ if(resc){ asm volatile("s_waitcnt lgkmcnt(0)":::"memory"); \
      _Pragma("unroll") for(int d_=0;d_<2;++d_) _Pragma("unroll") for(int r=0;r<16;++r)o[d_][r]*=wsf[crow(r,hi)]; } }while(0)
  f32x16 pA0,pA1,pB0,pB1;
  int sl_prev=0,sl_cur=0,sl_next=SLOTB;
  #define ROT() do{sl_prev=sl_cur;sl_cur=sl_next;sl_next=(sl_next==(NSLOT-1)*SLOTB)?0:sl_next+SLOTB;}while(0)
  DMA_K(2,2*SLOTB);
  WAIT_BAR(3);
  qkt(pA0,pA1,Kbase,qr,negm,r32,hi);asm volatile("s_nop 15\n\ts_nop 7":"+v"(pA0),"+v"(pA1));CMASK(pA0,pA1,0);
  START(pA0,pA1);
  _Pragma("unroll") for(int r=0;r<16;++r)pA1[r]=__builtin_amdgcn_exp2f(pA1[r]);
  WAIT_BAR(0);
  DMA_K(3,0);DMA_V(1,SLOTB);
  ROT();
  kload8(kf,kp0+sl_cur);
  WAIT_BAR(2);
  s16x4 vlo[8],vhi[8]; u32x4 pw0,pw1,pw2,pw3;
  #define PKW(P,B) cvtpk_s(P[B],P[B+1])
  #define PAF(k) __builtin_bit_cast(bf16x8,pw##k)
  #define VFR(i) (bf16x8){vlo[i][0],vlo[i][1],vlo[i][2],vlo[i][3],vhi[i][0],vhi[i][1],vhi[i][2],vhi[i][3]}
  #define PIN(x) asm volatile("":"+v"(x))
  #define MX3(a,b,c) __builtin_fmaxf(__builtin_fmaxf((a),(b)),(c))
  #define GAPA(MF,A0,A1,A2,A3,W0,W1,PW) do{ MF; sacc+=A0; sacc+=A1; sacc+=A2; sacc+=A3; PIN(sacc); W0; W1; PIN(PW); SBAR(); }while(0)
  #define EX(v) __builtin_amdgcn_exp2f(v)
  #define GAPB(MF,X,B) do{ MF; X[B]=EX(X[B]); X[B+1]=EX(X[B+1]); X[B+2]=EX(X[B+2]); X[B+3]=EX(X[B+3]); PIN(X); SBAR(); }while(0)
  #define VRD(i) do{ vlo[i]=vtr(vp_+(((i)>>2)*4096+((i)&3)*1024)); vhi[i]=vtr(vp_+(((i)>>2)*4096+((i)&3)*1024+512)); }while(0)
  #define KRD(G,j) do{ if(G){ kload2(kf,kp0+sl_next,j); SBAR(); } }while(0)
  #define STEP(C0,C1,P0,P1,t,GK,GV,GL) do{ SBAR(); \
    const lds_cptr vp_=vp0+sl_prev; \
    VRD(0); SBAR(); float sacc=(P0[0]+P0[1]); \
    GAPA(C0=__builtin_amdgcn_mfma_f32_32x32x16_bf16(kf[0],qr[0],negm,0,0,0), P0[2],P0[3],P0[4],P0[5],     pw0[0]=PKW(P0,0), pw0[1]=PKW(P0,2), pw0); \
    VRD(4); SBAR(); GAPA(C1=__builtin_amdgcn_mfma_f32_32x32x16_bf16(kf[1],qr[0],negm,0,0,0), P0[6],P0[7],P0[8],P0[9],     pw0[2]=PKW(P0,4), pw0[3]=PKW(P0,6), pw0); \
    VRD(1); SBAR(); GAPA(C0=__builtin_amdgcn_mfma_f32_32x32x16_bf16(kf[2],qr[1],C0,0,0,0),   P0[10],P0[11],P0[12],P0[13], pw1[0]=PKW(P0,8), pw1[1]=PKW(P0,10), pw1); \
    VRD(5); SBAR(); GAPA(C1=__builtin_amdgcn_mfma_f32_32x32x16_bf16(kf[3],qr[1],C1,0,0,0),   P0[14],P0[15],P1[0],P1[1],   pw1[2]=PKW(P0,12),pw1[3]=PKW(P0,14), pw1); \
    VRD(2); SBAR(); GAPA(C0=__builtin_amdgcn_mfma_f32_32x32x16_bf16(kf[4],qr[2],C0,0,0,0),   P1[2],P1[3],P1[4],P1[5],     pw2[0]=PKW(P1,0), pw2[1]=PKW(P1,2), pw2); \
    VRD(6); SBAR(); GAPA(C1=__builtin_amdgcn_mfma_f32_32x32x16_bf16(kf[5],qr[2],C1,0,0,0),   P1[6],P1[7],P1[8],P1[9],     pw2[2]=PKW(P1,4), pw2[3]=PKW(P1,6), pw2); \
    VRD(3); SBAR(); GAPA(C0=__builtin_amdgcn_mfma_f32_32x32x16_bf16(kf[6],qr[3],C0,0,0,0),   P1[10],P1[11],P1[12],P1[13], pw3[0]=PKW(P1,8), pw3[1]=PKW(P1,10), pw3); \
    VRD(7); SBAR(); GAPA(C1=__builtin_amdgcn_mfma_f32_32x32x16_bf16(kf[7],qr[3],C1,0,0,0),   P1[14],P1[15],0.f,0.f,       pw3[2]=PKW(P1,12),pw3[3]=PKW(P1,14), pw3); \
    l_reg+=sacc; \
    if(GK){DMA_K((t)+3,sl_cur);} if(GV){DMA_V((t)+1,sl_next);} \
    CMASK(C0,C1,t); \
    { float a=MX3(C0[0],C0[1],C1[0]),b=MX3(C0[2],C0[3],C1[1]); a=MX3(a,C1[2],C1[3]); \
      _Pragma("unroll") for(int r=4;r<16;r+=4){a=MX3(a,C0[r],C0[r+1]);b=MX3(b,C0[r+2],C0[r+3]);a=MX3(a,C1[r],C1[r+1]);b=MX3(b,C1[r+2],C1[r+3]);} \
      float rm=__builtin_fmaxf(a,b); { auto rr=__builtin_amdgcn_permlane32_swap(__float_as_uint(rm),__float_as_uint(rm),false,false); rm=__builtin_fmaxf(__uint_as_float(rr[0]),__uint_as_float(rr[1])); } \
      resc=false; \
      if(__builtin_expect(__any(rm>(float)THRL),0)){ const float dl=__builtin_fmaxf(rm,0.f); mhat+=dl; \
        _Pragma("unroll") for(int r=0;r<16;++r){C0[r]-=dl;C1[r]-=dl;} \
        _Pragma("unroll") for(int r=0;r<16;++r)negm[r]=-mhat; asm volatile("":"+v"(negm)); \
        const float f=__builtin_amdgcn_exp2f(-dl); l_reg*=f; if(hi==0)wsf[r32]=f; resc=true; } } \
    SBAR(); \
    GAPB(o[0]=__builtin_amdgcn_mfma_f32_32x32x16_bf16(PAF(0),VFR(0),o[0],0,0,0), C0,0); \
    GAPB(o[1]=__builtin_amdgcn_mfma_f32_32x32x16_bf16(PAF(0),VFR(4),o[1],0,0,0), C0,4); \
    KRD(GL,0); GAPB(o[0]=__builtin_amdgcn_mfma_f32_32x32x16_bf16(PAF(1),VFR(1),o[0],0,0,0), C0,8); \
    KRD(GL,1); GAPB(o[1]=__builtin_amdgcn_mfma_f32_32x32x16_bf16(PAF(1),VFR(5),o[1],0,0,0), C0,12); \
    KRD(GL,2); GAPB(o[0]=__builtin_amdgcn_mfma_f32_32x32x16_bf16(PAF(2),VFR(2),o[0],0,0,0), C1,0); \
    KRD(GL,3); GAPB(o[1]=__builtin_amdgcn_mfma_f32_32x32x16_bf16(PAF(2),VFR(6),o[1],0,0,0), C1,4); \
    GAPB(o[0]=__builtin_amdgcn_mfma_f32_32x32x16_bf16(PAF(3),VFR(3),o[0],0,0,0), C1,8); \
    GAPB(o[1]=__builtin_amdgcn_mfma_f32_32x32x16_bf16(PAF(3),VFR(7),o[1],0,0,0), C1,12); \
    }while(0)
  int t=1;
  #define ENDW(tt) do{ if((tt)+3<NT){WAIT_BAR(2);} else if((tt)+2<NT){WAIT_BAR(1);} else {WAIT_BAR(0);} }while(0)
  for(;t+1<NT;t+=2){
    STEP(pB0,pB1,pA0,pA1,t,(t+3<NT),(t+1<NT),(t+1<NT));       ENDW(t);   RESC(); ROT();
    STEP(pA0,pA1,pB0,pB1,t+1,(t+4<NT),(t+2<NT),(t+2<NT));     ENDW(t+1); RESC(); ROT();
  }
  STEP(pB0,pB1,pA0,pA1,NT-1,false,false,false); RESC();
  { float sacc=pB0[0]+pB0[1]; _Pragma("unroll") for(int r=2;r<16;++r)sacc+=pB0[r]; _Pragma("unroll") for(int r=0;r<16;++r)sacc+=pB1[r]; l_reg+=sacc;
    pw0=(u32x4){PKW(pB0,0),PKW(pB0,2),PKW(pB0,4),PKW(pB0,6)};pw1=(u32x4){PKW(pB0,8),PKW(pB0,10),PKW(pB0,12),PKW(pB0,14)};pw2=(u32x4){PKW(pB1,0),PKW(pB1,2),PKW(pB1,4),PKW(pB1,6)};pw3=(u32x4){PKW(pB1,8),PKW(pB1,10),PKW(pB1,12),PKW(pB1,14)};
    SBAR(); pv(o,vb0+sl_cur,PAF(0),PAF(1),PAF(2),PAF(3)); }
  #undef PKW
  #undef PAF
  #undef VFR
  #undef PIN
  #undef MX3
  #undef GAPA
  #undef GAPB
  #undef EX
  #undef VRD
  #undef KRD
  #undef STEP
  #undef ENDW
  {auto rr=__builtin_amdgcn_permlane32_swap(__float_as_uint(l_reg),__float_as_uint(l_reg),false,false);l_reg=__uint_as_float(rr[0])+__uint_as_float(rr[1]);}
  if(hi==0)wsf[32+r32]=l_reg;asm volatile("s_waitcnt lgkmcnt(0)":::"memory");
  float rli[16];
  #pragma unroll
  for(int r=0;r<16;++r)rli[r]=__builtin_amdgcn_rcpf(wsf[32+crow(r,hi)]);
  bf16*Ow=O+(rowbase+q0+wid*QBLK)*QP+h*D;
  { bf16*stg=(bf16*)(shm+LDS_OST)+wid*2048;
    #pragma unroll
    for(int r=0;r<16;++r){const int orow=crow(r,hi);
      #pragma unroll
      for(int d0=0;d0<2;++d0)stg[orow*64+d0*32+r32]=__float2bfloat16(o[d0][r]*rli[r]);}
    asm volatile("s_waitcnt lgkmcnt(0)":::"memory");
    #pragma unroll
    for(int i=0;i<4;++i){const int row=i*8+(lane>>3),ch=lane&7; const u32x4 v=*(const u32x4*)(stg+row*64+ch*8); ATTN_STORE16(Ow+(long)row*QP+ch*8,v);} }
  asm volatile("s_waitcnt lgkmcnt(0)\n\ts_barrier":::"memory");
  #undef DMA_K
  #undef DMA_V
  #undef CMASK
  #undef START
  #undef RESC
  #undef ROT
}
constexpr int ATTN_LDS_BYTES=LDS_BYTES;
struct AttnTensors { const bf16* Q; const bf16* K; const bf16* V; bf16* O; const float* sinks; };
struct AttnUnit { int bh; int qb; };
struct StaticOrder {
  int vcu;
  __device__ __forceinline__ explicit StaticOrder(int grid,int block):vcu((block%8)*(grid/8)+block/8){}
  __device__ __forceinline__ bool next(int i,AttnUnit&u)const{ if(i>=4)return false; const int s=vcu&7; u.bh=vcu>>3; u.qb=(i==0)?s:(i==1)?15-s:(i==2)?16+s:31-s; return true; }
  __device__ __forceinline__ void a_ready(const AttnUnit&)const{}
  __device__ __forceinline__ void done(const AttnUnit&)const{}
};
template<class Sched,int THRL=8> __device__ __forceinline__ void attn_phase(char*lds,const AttnTensors&T,const Sched&S){
  AttnUnit u;
  for(int i=0;S.next(i,u);++i){ S.a_ready(u); attn_unit<THRL>(u.bh/NHEAD,u.bh%NHEAD,u.qb,T.Q,T.K,T.V,T.O,lds,T.sinks[u.bh%NHEAD]*1.4426950408889634f); S.done(u); }
}
#undef SBAR
#undef WAIT_BAR
}
#define GAS __attribute__((address_space(1)))
#define LAS __attribute__((address_space(3)))
typedef unsigned short bf16;
typedef unsigned v4u __attribute__((ext_vector_type(4)));
typedef float f32x4 __attribute__((ext_vector_type(4)));
typedef short bf16x8 __attribute__((ext_vector_type(8)));
typedef GAS unsigned gu32;
typedef GAS unsigned long long gu64;
#define RLX_AGENT __ATOMIC_RELAXED, __HIP_MEMORY_SCOPE_AGENT
#define LDS_WAIT() asm volatile("s_waitcnt lgkmcnt(0)" ::: "memory")
#define VM_WAIT() asm volatile("s_waitcnt vmcnt(0)" ::: "memory")
__device__ __forceinline__ unsigned long long rt() { return __builtin_amdgcn_s_memrealtime(); }
__device__ __forceinline__ unsigned f2bf(float f) { unsigned u = __builtin_bit_cast(unsigned, f); return (u + 0x7fffu + ((u >> 16) & 1u)) >> 16; }
__device__ __forceinline__ unsigned pk2(float lo, float hi) { return f2bf(lo) | (f2bf(hi) << 16); }

#define XB_TMO      128
#define XB_XCNT(j)  (256  + 64 * (j))
#define XB_XSUB(j)  (1280 + 64 * (j))
#define XB_XGEN(j)  (2304 + 64 * (j))
#define XB_TOP      3328
#define XB_TOPGEN   3392
#define XCD_BAR_WORDS 3456
#define XB_SPIN_CAP (1u << 18)

__device__ __forceinline__ unsigned xb_ld(unsigned* p)              { return __hip_atomic_load(p, __ATOMIC_RELAXED, __HIP_MEMORY_SCOPE_AGENT); }
__device__ __forceinline__ unsigned xb_add(unsigned* p, unsigned v) { return __hip_atomic_fetch_add(p, v, __ATOMIC_RELAXED, __HIP_MEMORY_SCOPE_AGENT); }
__device__ __forceinline__ unsigned xb_xcc_id() { return (unsigned)__builtin_amdgcn_s_getreg((3 << 11) | 20) & 0xFu; }
#define XB_SPIN(cond, bar) do { unsigned _sp = 0; while (cond) { __builtin_amdgcn_s_sleep(1); \
    if ((++_sp & 255u) == 0u) { if (xb_ld(&(bar)[XB_TMO])) break; if (_sp > XB_SPIN_CAP) { atomicAdd(&(bar)[XB_TMO], 1u); break; } } } } while (0)

struct XcdBarrier {
    unsigned* bar; unsigned x;
    volatile LAS unsigned* st;
};

__device__ __forceinline__ XcdBarrier xcd_barrier_post(unsigned* bar, volatile LAS unsigned* st) {
    XcdBarrier b; b.bar = bar; b.x = xb_xcc_id(); b.st = st;
    if (threadIdx.x == 0) (void)xb_add(&bar[XB_XCNT(b.x)], 1u);
    return b;
}
__device__ __forceinline__ void xcd_barrier_complete(unsigned* bar, unsigned x, unsigned& nloc, unsigned& nx) {
    const unsigned G = gridDim.x * gridDim.y * gridDim.z;
    unsigned sum, cnt, mine, sp = 0u;
    for (;;) {
        sum = 0u; cnt = 0u; mine = 0u;
#pragma unroll
        for (unsigned j = 0; j < 16; ++j) { const unsigned c = xb_ld(&bar[XB_XCNT(j)]); sum += c; cnt += (c > 0u) ? 1u : 0u; mine = (j == x) ? c : mine; }
        if (sum == G) break;
        __builtin_amdgcn_s_sleep(1);
        if ((++sp & 255u) == 0u) { if (xb_ld(&bar[XB_TMO])) break; if (sp > XB_SPIN_CAP) { atomicAdd(&bar[XB_TMO], 1u); break; } }
    }
    nloc = mine > 0u ? mine : 1u; nx = cnt > 0u ? cnt : 1u;
}

__device__ __forceinline__ void xcd_barrier(const XcdBarrier& b) {
    asm volatile("s_waitcnt vmcnt(0)" ::: "memory");
    __syncthreads();
    if (threadIdx.x == 0) {
        unsigned* bar = b.bar;
        __builtin_amdgcn_s_waitcnt(0);
        unsigned nloc = b.st[0], nx = b.st[1];
        if (nloc == 0u) { unsigned xo = b.x; asm volatile("" : "+s"(xo)); xcd_barrier_complete(bar, xo, nloc, nx); b.st[0] = nloc; b.st[1] = nx; }
        const unsigned old = xb_add(&bar[XB_XSUB(b.x)], 1u);
        const unsigned gen = old / nloc;
        if (old + 1u == (gen + 1u) * nloc) {
            __builtin_amdgcn_fence(__ATOMIC_RELEASE, "agent");
            asm volatile("s_waitcnt vmcnt(0)" ::: "memory");
            const unsigned og = xb_add(&bar[XB_TOP], 1u);
            const unsigned tg = og / nx;
            if (og + 1u == (tg + 1u) * nx) xb_add(&bar[XB_TOPGEN], 1u);
            else XB_SPIN(xb_ld(&bar[XB_TOPGEN]) == tg, bar);
            __builtin_amdgcn_fence(__ATOMIC_ACQUIRE, "agent");
            xb_add(&bar[XB_XGEN(b.x)], 1u);
            asm volatile("s_waitcnt vmcnt(0)" ::: "memory");
        } else {
            XB_SPIN(xb_ld(&bar[XB_XGEN(b.x)]) == gen, bar);
            __builtin_amdgcn_fence(__ATOMIC_ACQUIRE, "agent");
            asm volatile("s_waitcnt vmcnt(0)" ::: "memory");
        }
    }
    __syncthreads();
}
constexpr int DM = 1024, MP = 16384, MS = 128, MT = MP + MS, DFF = 2816;
constexpr float EPS = 1e-6f;
constexpr float LOG2E = 1.4426950408889634f;
constexpr size_t O_X = 0, O_SSMRE_P = 16908288, O_SSMIM_P = 16924672, O_WINK_P = 16941056, O_WINV_P = 17072128, O_MEMK_P = 17203200, O_MEMV_P = 19300352,
                 O_SSMRE_S = 21397504, O_SSMIM_S = 22446080, O_WINK_S = 23494656, O_WINV_S = 31883264, O_TOTAL = 40271872;
constexpr size_t MiB = 1u << 20;
constexpr size_t WS_CTL = 0, CTL_ZERO_BYTES = 1 * MiB;
constexpr size_t SZ_WIN = 11 * MiB, SZ_WOUT = 11 * MiB / 2;
constexpr size_t WS_WIN = 1 * MiB, WS_WOUT = 89 * MiB, WS_WGLU = 133 * MiB, WS_WQKV = 141 * MiB, WS_WAO = 147 * MiB, WS_CWQ = 151 * MiB, WS_CWO = 159 * MiB, WS_CWKV = 167 * MiB;
constexpr size_t WS_KMAT = 183 * MiB, SZ_KMAT = 40 * MiB, WS_BMAT = 263 * MiB, SZ_BMAT = 16 * MiB, WS_KTAB = 295 * MiB, SZ_KTAB = 2 * MiB, WS_PAR = 299 * MiB, SZ_PAR = 2 * MiB, WS_POW = 303 * MiB, SZ_POW = 2 * MiB;
constexpr size_t WS_XN = 307 * MiB, WS_XP = 340 * MiB, WS_H = 380 * MiB, WS_Y = 469 * MiB, WS_QB = 534 * MiB, WS_KB = 567 * MiB, WS_VB = 576 * MiB, WS_PB = 585 * MiB, WS_SLOC = 617 * MiB;
constexpr size_t WS_MEMN = 633 * MiB, WS_MEMK = 637 * MiB, WS_MEMVT = 641 * MiB, WS_QS = 645 * MiB, WS_END = 646 * MiB;
static_assert(WS_XN + (size_t)MT * DM * 2 <= WS_XP && WS_H + (size_t)MT * DFF * 2 <= WS_Y && WS_Y + (size_t)MT * DM * 4 <= WS_QB && WS_QB + (size_t)MT * DM * 2 <= WS_KB && WS_KB + (size_t)MT * 256 * 2 <= WS_VB && WS_VB + (size_t)MT * 256 * 2 <= WS_PB, "ws map");
constexpr int PAR_STRIDE = 68;
constexpr int CW_TMO = 0, CW_BAR = 4096;
constexpr int NWAVES = 8;
constexpr int RING_OFF = 0, RING_BYTES = 131072, LDSCTL_OFF = RING_BYTES, MISC_OFF = LDSCTL_OFF + 320, LDS_BYTES = 147456;
__device__ __forceinline__ float wave_sum_l(float v, int lane) {
#pragma unroll
    for (int o = 1; o < 64; o <<= 1) v += pg8::shflx(v, o, lane);
    return v;
}
__device__ __forceinline__ float wave_max_l(float v, int lane) {
#pragma unroll
    for (int o = 1; o < 64; o <<= 1) v = fmaxf(v, pg8::shflx(v, o, lane));
    return v;
}
#define wave_sum(x) wave_sum_l((x), lane)
#define wave_max(x) wave_max_l((x), lane)
__device__ __forceinline__ float bf2f(unsigned short h) { return __uint_as_float((unsigned)h << 16); }

__device__ __forceinline__ void transpose_item(const float* W, int K, int N, bf16* WT, int mapmode, LAS float* scr, int item, int lane) {
    const int nblk = N / 32, kb = item / nblk, nb = item % nblk, k0 = 64 * kb, n0 = 32 * nb;
#pragma unroll 8
    for (int i = 0; i < 32; ++i) { const int kk = 2 * i + (lane >> 5); scr[kk * 33 + (lane & 31)] = W[(size_t)(k0 + kk) * N + n0 + (lane & 31)]; }
    LDS_WAIT(); asm volatile("" ::: "memory");
    int r0 = n0;
    if (mapmode == 1) { const int NH = N >> 1; if (n0 < NH) r0 = (n0 >> 7) * 256 + (n0 & 127); else { const int j = n0 - NH; r0 = (j >> 7) * 256 + 128 + (j & 127); } }
    const int c = lane & 7;
#pragma unroll
    for (int j = 0; j < 4; ++j) { const int n = (lane >> 3) + 8 * j; const LAS float* s = scr + (8 * c) * 33 + n;
        v4u o; o.x = pk2(s[0 * 33], s[1 * 33]); o.y = pk2(s[2 * 33], s[3 * 33]); o.z = pk2(s[4 * 33], s[5 * 33]); o.w = pk2(s[6 * 33], s[7 * 33]);
        *(GAS v4u*)(WT + (size_t)(r0 + n) * K + k0 + 8 * c) = o; }
    LDS_WAIT(); asm volatile("" ::: "memory");
}

__device__ __forceinline__ void thin_rows(int gw, int NGW, int lane, float* X, const float* Y, float scale, const float* gpost, const float* gpre, bf16* XN, bf16* XP, int mode) {
    f32x4 gp[4], gn[4];
#pragma unroll
    for (int j = 0; j < 4; ++j) { gp[j] = *(const f32x4*)(gpost + 4 * lane + 256 * j); gn[j] = (mode != 2) ? *(const f32x4*)(gpre + 4 * lane + 256 * j) : (f32x4){0.f, 0.f, 0.f, 0.f}; }
    for (int row = gw; row < MT; row += NGW) {
        const GAS f32x4* yr = (const GAS f32x4*)(Y + (size_t)row * DM) + lane; GAS f32x4* xr = (GAS f32x4*)(X + (size_t)row * DM) + lane;
        f32x4 y[4], x[4]; float s = 0.f;
#pragma unroll
        for (int j = 0; j < 4; ++j) { y[j] = yr[64 * j]; x[j] = xr[64 * j]; s += (y[j].x * y[j].x + y[j].y * y[j].y) + (y[j].z * y[j].z + y[j].w * y[j].w); }
        const float r = scale / sqrtf(wave_sum(s) * (1.f / DM) + EPS); float s2 = 0.f;
#pragma unroll
        for (int j = 0; j < 4; ++j) { x[j] = x[j] + y[j] * gp[j] * r; xr[64 * j] = x[j]; s2 += (x[j].x * x[j].x + x[j].y * x[j].y) + (x[j].z * x[j].z + x[j].w * x[j].w); }
        if (mode != 2) {
            const float r2 = 1.f / sqrtf(wave_sum(s2) * (1.f / DM) + EPS);
            bf16* dst = (mode == 1 && row < MP) ? XP + ((size_t)(row >> 5) * 40 + (row & 31)) * DM : XN + (size_t)row * DM;
            GAS unsigned long long* o8 = (GAS unsigned long long*)dst + lane;
#pragma unroll
            for (int j = 0; j < 4; ++j) { const f32x4 o = x[j] * gn[j] * r2; o8[64 * j] = (unsigned long long)pk2(o.x, o.y) | ((unsigned long long)pk2(o.z, o.w) << 32); }
        }
    }
}
__device__ __forceinline__ void first_rows(int gw, int NGW, int lane, float* X, const float* xp, const float* xs, const float* gpre, bf16* XN) {
    f32x4 gn[4];
#pragma unroll
    for (int j = 0; j < 4; ++j) gn[j] = *(const f32x4*)(gpre + 4 * lane + 256 * j);
    for (int row = gw; row < MT; row += NGW) {
        const float* src = (row < MP) ? xp + (size_t)row * DM : xs + (size_t)(row - MP) * DM;
        const GAS f32x4* sr = (const GAS f32x4*)src + lane; GAS f32x4* xr = (GAS f32x4*)(X + (size_t)row * DM) + lane;
        f32x4 x[4]; float s2 = 0.f;
#pragma unroll
        for (int j = 0; j < 4; ++j) { x[j] = sr[64 * j]; xr[64 * j] = x[j]; s2 += (x[j].x * x[j].x + x[j].y * x[j].y) + (x[j].z * x[j].z + x[j].w * x[j].w); }
        const float r2 = 1.f / sqrtf(wave_sum(s2) * (1.f / DM) + EPS);
        GAS unsigned long long* o8 = (GAS unsigned long long*)(XN + (size_t)row * DM) + lane;
#pragma unroll
        for (int j = 0; j < 4; ++j) { const f32x4 o = x[j] * gn[j] * r2; o8[64 * j] = (unsigned long long)pk2(o.x, o.y) | ((unsigned long long)pk2(o.z, o.w) << 32); }
    }
}

typedef float f32x4_t __attribute__((ext_vector_type(4)));
template <int NB, class Epi>
__device__ __forceinline__ void skinny_gemm(const bf16* A, int lda, const bf16* Bt, int ldb, int K, int ngroups, const Epi& E, int first, int G, int wave, int lane) {
    for (int cg = first; cg < ngroups; cg += G) {
        const bf16* ap = A + (size_t)(wave * 16 + (lane & 15)) * lda + 8 * (lane >> 4);
        const int col = cg * 16 + (lane & 15);
        const bf16* bp0 = Bt + (size_t)E.brow0(col) * ldb + 8 * (lane >> 4);
        const bf16* bp1 = (NB == 2) ? Bt + (size_t)E.brow1(col) * ldb + 8 * (lane >> 4) : bp0;
        f32x4_t acc0 = {0.f, 0.f, 0.f, 0.f}, acc1 = {0.f, 0.f, 0.f, 0.f};
        for (int k = 0; k < K; k += 128) {
            bf16x8 a[4], b0[4], b1[4];
#pragma unroll
            for (int i = 0; i < 4; ++i) { a[i] = *(const bf16x8*)(ap + k + 32 * i); b0[i] = *(const bf16x8*)(bp0 + k + 32 * i); if (NB == 2) b1[i] = *(const bf16x8*)(bp1 + k + 32 * i); }
#pragma unroll
            for (int i = 0; i < 4; ++i) { acc0 = __builtin_amdgcn_mfma_f32_16x16x32_bf16(a[i], b0[i], acc0, 0, 0, 0); if (NB == 2) acc1 = __builtin_amdgcn_mfma_f32_16x16x32_bf16(a[i], b1[i], acc1, 0, 0, 0); }
        }
        E.store(acc0, acc1, col, wave * 16 + 4 * (lane >> 4));
    }
}
struct SkF32 {
    float* O; int ldo; const float* bias;
    __device__ __forceinline__ int brow0(int col) const { return col; }
    __device__ __forceinline__ int brow1(int col) const { return col; }
    __device__ __forceinline__ void store(f32x4_t a0, f32x4_t, int col, int row0) const { const float b = bias ? bias[col] : 0.f;
#pragma unroll
        for (int e = 0; e < 4; ++e) O[(size_t)(row0 + e) * ldo + col] = a0[e] + b; }
};
struct SkSwiGLU {
    bf16* H;
    __device__ __forceinline__ int brow0(int col) const { return (col >> 7) * 256 + (col & 127); }
    __device__ __forceinline__ int brow1(int col) const { return (col >> 7) * 256 + 128 + (col & 127); }
    __device__ __forceinline__ void store(f32x4_t a0, f32x4_t a1, int col, int row0) const {
#pragma unroll
        for (int e = 0; e < 4; ++e) { const float gt = a0[e]; H[(size_t)(row0 + e) * DFF + col] = (bf16)f2bf(gt * pg8::sigmoid_f(gt) * a1[e]); } }
};
struct SkGLU {
    float* Y; const float* bias;
    __device__ __forceinline__ int brow0(int col) const { return (col >> 7) * 256 + (col & 127); }
    __device__ __forceinline__ int brow1(int col) const { return (col >> 7) * 256 + 128 + (col & 127); }
    __device__ __forceinline__ void store(f32x4_t a0, f32x4_t a1, int col, int row0) const { const float ba = bias[col], bg = bias[1024 + col];
#pragma unroll
        for (int e = 0; e < 4; ++e) Y[(size_t)(row0 + e) * DM + col] = (a0[e] + ba) * pg8::sigmoid_f(a1[e] + bg); }
};

template <int LDA_, int LDB_, int NT_> struct GD_Plain { static constexpr int AMODE = 0, LDA = LDA_, LDB = LDB_, NT = NT_, KSTEPA = 128, KSTEPB = 128; const char* A; const char* B;
    __device__ __forceinline__ const char* aptr(const pg8::Unit& u) const { return A + (size_t)u.pm * 256 * LDA * 2; }
    __device__ __forceinline__ const char* bptr(const pg8::Unit& u) const { return B + (size_t)u.pn * 256 * LDB * 2; } };
struct GD_MemKV { static constexpr int AMODE = 0, LDA = 1024, LDB = 1024, NT = 16, KSTEPA = 128, KSTEPB = 128; const char* A; const char* B;
    __device__ __forceinline__ const char* aptr(const pg8::Unit& u) const { return A + (size_t)u.pm * 256 * 1024 * 2; }
    __device__ __forceinline__ const char* bptr(const pg8::Unit& u) const { return B + ((size_t)(u.pm >> 1) * 2048 + (size_t)u.pn * 256) * 1024 * 2; } };
struct GD_SsmA { static constexpr int AMODE = 1, LDA = 40960, LDB = 512, NT = 8, KSTEPA = 8192, KSTEPB = 128; const char* A; const char* B;
    __device__ __forceinline__ const char* aptr(const pg8::Unit& u) const { return A + (size_t)u.pm * 256 * 40960 * 2 + (size_t)u.pn * 32; }
    __device__ __forceinline__ const char* bptr(const pg8::Unit& u) const { return B + (size_t)u.pn * 256 * 512 * 2; } };
struct GD_SsmB { static constexpr int AMODE = 1, LDA = 40960, LDB = 640, NT = 10, KSTEPA = 8192, KSTEPB = 128; const char* A; const char* B;
    __device__ __forceinline__ const char* aptr(const pg8::Unit& u) const { return A + (size_t)u.pm * 256 * 40960 * 2 + (size_t)(u.pn >> 1) * 32; }
    __device__ __forceinline__ const char* bptr(const pg8::Unit& u) const { return B + ((size_t)(u.pn >> 1) * 512 + (size_t)(u.pn & 1) * 256) * 640 * 2; } };
struct GD_CaS { static constexpr int AMODE = 0, LDA = 1024, LDB = 1024, NT = 4, KSTEPA = 128, KSTEPB = 128; const char* A; const char* B;
    __device__ __forceinline__ const char* aptr(const pg8::Unit& u) const { return A + ((size_t)u.pm * 256 * 1024 + (size_t)u.pn * 256) * 2; }
    __device__ __forceinline__ const char* bptr(const pg8::Unit& u) const { return B + ((size_t)(u.pm >> 5) * 256 * 1024 + (size_t)u.pn * 256) * 2; } };
struct GD_CaPV { static constexpr int AMODE = 0, LDA = 1024, LDB = 256, NT = 4, KSTEPA = 128, KSTEPB = 128; const char* A; const char* B;
    __device__ __forceinline__ const char* aptr(const pg8::Unit& u) const { return A + ((size_t)u.pm * 256 * 1024 + (size_t)u.pn * 256) * 2; }
    __device__ __forceinline__ const char* bptr(const pg8::Unit& u) const { return B + ((size_t)(u.pm >> 5) * 4 + (size_t)u.pn) * 256 * 256 * 2; } };
__device__ __forceinline__ void ssm_par_item(int idx, const float* a_re, const float* a_im, const float* log_dt, const float* b_re, const float* b_im, const float* c_re, const float* c_im, float* PAR, float* POW) {
    const int s = idx >> 12, g = (idx >> 6) & 63, p = idx & 63;
    const float dt = expf(log_dt[s * 64 + g]);
    const float ar = a_re[(s * 64 + g) * 64 + p], ai = a_im[(s * 64 + g) * 64 + p];
    const float mag = expf(ar * dt), lr = mag * cosf(ai * dt), li = mag * sinf(ai * dt);
    const float den = ar * ar + ai * ai, nr = lr - 1.0f, ni = li;
    const float zr = (nr * ar + ni * ai) / den, zi = (ni * ar - nr * ai) / den;
    float* par = PAR + ((size_t)(s * 64 + g) * 64 + p) * PAR_STRIDE;
    par[0] = lr; par[1] = li;
    for (int j = 0; j < 16; ++j) { const float br = b_re[((size_t)(s * 64 + g) * 64 + p) * 16 + j], bi = b_im[((size_t)(s * 64 + g) * 64 + p) * 16 + j];
        par[4 + j] = zr * br - zi * bi; par[20 + j] = zr * bi + zi * br; }
    for (int i = 0; i < 16; ++i) { par[36 + i] = c_re[((size_t)(s * 64 + g) * 16 + i) * 64 + p]; par[52 + i] = c_im[((size_t)(s * 64 + g) * 16 + i) * 64 + p]; }
    float* pw = POW + ((size_t)(s * 64 + g) * 64 + p) * 66;
    float pr = 1.f, pi = 0.f;
    for (int t = 0; t <= 32; ++t) { pw[2 * t] = pr; pw[2 * t + 1] = pi; const float nr2 = pr * lr - pi * li, ni2 = pr * li + pi * lr; pr = nr2; pi = ni2; }
    par[2] = pw[64]; par[3] = pw[65];
}
__device__ __forceinline__ void ssm_ktab_item(int item, int lane, const float* PAR, const float* POW, float* KTAB) {
    const int sg = item >> 5, tau = item & 31;
    float acc[4] = {0.f, 0.f, 0.f, 0.f};
    for (int p = 0; p < 64; ++p) {
        const float* par = PAR + ((size_t)sg * 64 + p) * PAR_STRIDE; const float* pw = POW + ((size_t)sg * 64 + p) * 66 + 2 * tau;
        const float wr = pw[0], wi = pw[1];
#pragma unroll
        for (int q = 0; q < 4; ++q) { const int ij = lane + 64 * q, i = ij >> 4, j = ij & 15;
            const float cr = par[36 + i], ci = par[52 + i], xr = cr * wr - ci * wi, xi = cr * wi + ci * wr;
            acc[q] += xr * par[4 + j] - xi * par[20 + j]; }
    }
#pragma unroll
    for (int q = 0; q < 4; ++q) KTAB[((size_t)sg * 32 + tau) * 256 + lane + 64 * q] = acc[q];
}
__device__ __forceinline__ void ssm_bmat_item(size_t it, const float* PAR, const float* POW, bf16* BMAT) {
    const int c8 = (int)(it & 63), k = (int)((it >> 6) & 255); const int sg = (int)(it >> 14);
    v4u o = {0u, 0u, 0u, 0u};
    if (k < 128) { const int p = k & 63, sp = c8 >> 1, j0 = (c8 & 1) * 8;
        const float* par = PAR + ((size_t)sg * 64 + p) * PAR_STRIDE; const float* pw = POW + ((size_t)sg * 64 + p) * 66 + 2 * (31 - sp);
        const float wr = pw[0], wi = pw[1]; float v[8];
#pragma unroll
        for (int e = 0; e < 8; ++e) { const float br = par[4 + j0 + e], bi = par[20 + j0 + e]; v[e] = (k < 64) ? (wr * br - wi * bi) : (wr * bi + wi * br); }
        o.x = pk2(v[0], v[1]); o.y = pk2(v[2], v[3]); o.z = pk2(v[4], v[5]); o.w = pk2(v[6], v[7]); }
    *(GAS v4u*)(BMAT + ((size_t)sg * 256 + k) * 512 + c8 * 8) = o;
}
__device__ __forceinline__ void ssm_kmat_state_item(size_t it, const float* PAR, const float* POW, bf16* KMAT) {
    const int k8 = (int)(it & 15), row = (int)((it >> 4) & 511); const int sg = (int)(it >> 13);
    const int t = row >> 4, i = row & 15; float v[8];
#pragma unroll
    for (int e = 0; e < 8; ++e) { const int k = k8 * 8 + e, p = k & 63;
        const float* par = PAR + ((size_t)sg * 64 + p) * PAR_STRIDE; const float* pw = POW + ((size_t)sg * 64 + p) * 66 + 2 * (t + 1);
        const float cr = par[36 + i], ci = par[52 + i], wr = pw[0], wi = pw[1];
        v[e] = (k < 64) ? (cr * wr - ci * wi) : -(cr * wi + ci * wr); }
    v4u o; o.x = pk2(v[0], v[1]); o.y = pk2(v[2], v[3]); o.z = pk2(v[4], v[5]); o.w = pk2(v[6], v[7]);
    *(GAS v4u*)(KMAT + ((size_t)sg * 512 + row) * 640 + 512 + k8 * 8) = o;
}
__device__ __forceinline__ void ssm_kmat_toep_item(size_t it, const float* KTAB, bf16* KMAT) {
    const int c8 = (int)(it & 63), row = (int)((it >> 6) & 511); const int sg = (int)(it >> 15);
    const int t = row >> 4, i = row & 15, sp = c8 >> 1, j0 = (c8 & 1) * 8;
    v4u o = {0u, 0u, 0u, 0u};
    if (sp <= t) { const float* kt = KTAB + ((size_t)sg * 32 + (t - sp)) * 256 + i * 16 + j0;
        o.x = pk2(kt[0], kt[1]); o.y = pk2(kt[2], kt[3]); o.z = pk2(kt[4], kt[5]); o.w = pk2(kt[6], kt[7]); }
    *(GAS v4u*)(KMAT + ((size_t)sg * 512 + row) * 640 + c8 * 8) = o;
}

__device__ __forceinline__ void ssm_carry(int wg, int tid, LAS unsigned char* lds, const float* SLOC, const float* PAR, bf16* XP, float* out_re, float* out_im) {
    const int b = wg >> 7, g = (wg >> 1) & 63, ph = wg & 1;
    const int pl = tid & 31, seg = tid >> 5, p = ph * 32 + pl;
    const float* par = PAR + ((size_t)g * 64 + p) * PAR_STRIDE;
    const float ar = par[2], ai = par[3];
    float vr[16], vi[16];
#pragma unroll
    for (int k = 0; k < 16; ++k) { const size_t chunk = (size_t)b * 256 + seg * 16 + k; vr[k] = SLOC[chunk * 8192 + g * 128 + p]; vi[k] = SLOC[chunk * 8192 + g * 128 + 64 + p]; }
    float er = 0.f, ei = 0.f;
#pragma unroll
    for (int k = 0; k < 16; ++k) { const float nr = ar * er - ai * ei + vr[k], ni = ar * ei + ai * er + vi[k]; er = nr; ei = ni; }
    LAS float* E = (LAS float*)lds;
    E[(seg * 32 + pl) * 2] = er; E[(seg * 32 + pl) * 2 + 1] = ei;
    float a16r = ar, a16i = ai;
#pragma unroll
    for (int q = 0; q < 4; ++q) { const float nr = a16r * a16r - a16i * a16i, ni = 2.f * a16r * a16i; a16r = nr; a16i = ni; }
    __syncthreads();
    float hr = 0.f, hi = 0.f;
    for (int s2 = 0; s2 < seg; ++s2) { const float xr = E[(s2 * 32 + pl) * 2], xi = E[(s2 * 32 + pl) * 2 + 1]; const float nr = a16r * hr - a16i * hi + xr, ni = a16r * hi + a16i * hr + xi; hr = nr; hi = ni; }
#pragma unroll
    for (int k = 0; k < 16; ++k) {
        const size_t chunk = (size_t)b * 256 + seg * 16 + k;
        bf16* st = XP + (chunk * 40 + 32) * DM + g * 16;
        st[(size_t)(p >> 4) * DM + (p & 15)] = (bf16)f2bf(hr);
        st[(size_t)(4 + (p >> 4)) * DM + (p & 15)] = (bf16)f2bf(hi);
        const float nr = ar * hr - ai * hi + vr[k], ni = ar * hi + ai * hr + vi[k]; hr = nr; hi = ni;
    }
    if (seg == 15) { out_re[((size_t)b * 64 + g) * 64 + p] = hr; out_im[((size_t)b * 64 + g) * 64 + p] = hi; }
    __syncthreads();
}

__device__ __forceinline__ void ssm_sample_item(int item, int lane, const bf16* XNs, const float* PAR, const float* h0r, const float* h0i, const float* dskip, float* out_re, float* out_im, bf16* Gs) {
    const int b = item >> 6, g = item & 63;
    const float* par = PAR + ((size_t)g * 64 + lane) * PAR_STRIDE;
    const bf16* ur = XNs + (size_t)b * DM + g * 16;
    float u[16];
#pragma unroll
    for (int j = 0; j < 16; ++j) u[j] = bf2f(ur[j]);
    float br = 0.f, bi = 0.f;
#pragma unroll
    for (int j = 0; j < 16; ++j) { br += par[4 + j] * u[j]; bi += par[20 + j] * u[j]; }
    const size_t si = ((size_t)b * 64 + g) * 64 + lane;
    const float pr = h0r[si], pi = h0i[si], lr = par[0], li = par[1];
    const float hr = lr * pr - li * pi + br, hi = lr * pi + li * pr + bi;
    out_re[si] = hr; out_im[si] = hi;
    float myy = 0.f;
#pragma unroll
    for (int i = 0; i < 16; ++i) { const float y = wave_sum(par[36 + i] * hr - par[52 + i] * hi); if (lane == i) myy = y; }
    if (lane < 16) { const float v = myy + dskip[g * 16 + lane] * u[lane]; const pg8::f32x2 r = pg8::gelu_pk((pg8::f32x2){v, v}); Gs[(size_t)b * DM + g * 16 + lane] = (bf16)f2bf(r.x); }
}
__device__ __forceinline__ void swa_sample_item(int item, int tid, LAS unsigned char* lds, const float* QS  , const float* ck, const float* cv  ,
                                                const float* sinks, float* outk, float* outv  , bf16* Os  ) {
    const int b = item >> 2, kvh = item & 3, wave = tid >> 6, lane = tid & 63;
    LAS float* Kt = (LAS float*)lds; LAS float* Vt = Kt + 129 * 65 + 3; LAS float* qs = Vt + 129 * 64; LAS float* pb = qs + 256;
    for (int e = tid; e < 129 * 64; e += 512) { const int j = e >> 6, d = e & 63; float kv, vv;
        if (j < 128) { const size_t ci = (((size_t)b * 128 + j) * 4 + kvh) * 64 + d; kv = ck[ci]; vv = cv[ci]; }
        else { kv = QS[(size_t)b * 1536 + 1024 + kvh * 64 + d]; vv = QS[(size_t)b * 1536 + 1280 + kvh * 64 + d]; }
        Kt[j * 65 + d] = kv; Vt[j * 64 + d] = vv;
        if (j >= 1) { const size_t oi = (((size_t)b * 128 + (j - 1)) * 4 + kvh) * 64 + d; outk[oi] = kv; outv[oi] = vv; } }
    if (tid < 256) qs[tid] = QS[(size_t)b * 1536 + (kvh * 4 + (tid >> 6)) * 64 + (tid & 63)];
    __syncthreads();
    if (wave < 4) { const int h = kvh * 4 + wave; const LAS float* q = qs + wave * 64;
        float s0 = 0.f, s1 = 0.f, s2 = 0.f;
        for (int d = 0; d < 64; ++d) { const float qd = q[d]; s0 += qd * Kt[lane * 65 + d]; s1 += qd * Kt[(lane + 64) * 65 + d]; s2 += qd * Kt[128 * 65 + d]; }
        s0 *= 0.125f; s1 *= 0.125f; s2 *= 0.125f;
        const float sk = sinks[h];
        const float m = fmaxf(fmaxf(wave_max(fmaxf(s0, s1)), s2), sk);
        const float e0 = expf(s0 - m), e1 = expf(s1 - m), e2 = expf(s2 - m);
        const float inv = 1.f / (wave_sum(e0 + e1) + e2 + expf(sk - m));
        pb[wave * 132 + lane] = e0 * inv; pb[wave * 132 + 64 + lane] = e1 * inv; if (lane == 0) pb[wave * 132 + 128] = e2 * inv; }
    __syncthreads();
    if (wave < 4) { const int h = kvh * 4 + wave; float o = 0.f;
        for (int j = 0; j < 129; ++j) o += pb[wave * 132 + j] * Vt[j * 64 + lane];
        Os[(size_t)b * DM + h * 64 + lane] = (bf16)f2bf(o); }
    __syncthreads();
}
__device__ __forceinline__ void ca_sample_item(int item, int tid, LAS unsigned char* lds, const float* Qf  , const float* mk, const float* mv  , bf16* Os) {
    const int b = item >> 2, h = item & 3, wave = tid >> 6, lane = tid & 63;
    LAS float* sc = (LAS float*)lds; LAS float* part = sc + 256;
    const f32x4 q = *(const f32x4*)(Qf + (size_t)b * DM + h * 256 + 4 * lane);
    const float* kb = mk + (((size_t)b * 256) * 4 + h) * 256 + 4 * lane; const float* vb = mv + (((size_t)b * 256) * 4 + h) * 256 + 4 * lane;
    for (int m0 = wave * 32; m0 < wave * 32 + 32; m0 += 8) { f32x4 kk[8];
#pragma unroll
        for (int i = 0; i < 8; ++i) kk[i] = __builtin_nontemporal_load((const f32x4*)(kb + (size_t)(m0 + i) * 1024));
#pragma unroll
        for (int i = 0; i < 8; ++i) { const float d = wave_sum((kk[i].x * q.x + kk[i].y * q.y) + (kk[i].z * q.z + kk[i].w * q.w)); if (lane == 0) sc[m0 + i] = d * 0.0625f; } }
    __syncthreads();
    float mx = fmaxf(fmaxf(sc[lane], sc[lane + 64]), fmaxf(sc[lane + 128], sc[lane + 192])); mx = wave_max(mx);
    float sm = expf(sc[lane] - mx) + expf(sc[lane + 64] - mx) + expf(sc[lane + 128] - mx) + expf(sc[lane + 192] - mx); sm = wave_sum(sm);
    const float inv = 1.f / sm;
    f32x4 acc = {0.f, 0.f, 0.f, 0.f};
    for (int m0 = wave * 32; m0 < wave * 32 + 32; m0 += 8) { f32x4 vv[8];
#pragma unroll
        for (int i = 0; i < 8; ++i) vv[i] = __builtin_nontemporal_load((const f32x4*)(vb + (size_t)(m0 + i) * 1024));
#pragma unroll
        for (int i = 0; i < 8; ++i) { const float p = expf(sc[m0 + i] - mx) * inv; acc = acc + vv[i] * p; } }
    *(LAS f32x4*)(part + wave * 256 + 4 * lane) = acc;
    __syncthreads();
    if (tid < 256) { float o = 0.f;
#pragma unroll
        for (int w = 0; w < 8; ++w) o += part[w * 256 + tid];
        Os[(size_t)b * DM + h * 256 + tid] = (bf16)f2bf(o); }
    __syncthreads();
}
struct Args { const float* in[30]; float* out; unsigned char* ws; };
enum { I_XP = 0, I_XS, I_MEM, I_SRE, I_SIM, I_CWK, I_CWV, I_CMK, I_CMV, I_NG, I_MNG, I_FWIN, I_FWOUT, I_ARE, I_AIM, I_LDT, I_BRE, I_BIM, I_CRE, I_CIM, I_SD, I_WGLU, I_BGLU,
       I_WQKV, I_BQKV, I_WAO, I_SINK, I_CWQ, I_CWKV, I_CWO };

template <int OFF> __device__ __forceinline__ const void* karg() {
    const GAS char* p; const auto base = __builtin_amdgcn_kernarg_segment_ptr();
    asm volatile("s_load_dwordx2 %0, %1, %2\n\ts_waitcnt lgkmcnt(0)" : "=s"(p) : "s"(base), "n"(OFF) : "memory");
    return (const void*)p;
}
#define INP(i) ((const float*)karg<8 * (i)>())
#define OUTP() ((float*)karg<240>())
#define WSP() ((unsigned char*)karg<248>())
#define PHASE_IDS int tid = threadIdx.x; asm volatile("" : "+v"(tid)); const int lane = tid & 63, wave = __builtin_amdgcn_readfirstlane(tid >> 6); int G = gridDim.x, bid = blockIdx.x; asm volatile("" : "+s"(G), "+s"(bid)); \
    const int gw = bid * NWAVES + wave, NGW = G * NWAVES; const size_t gt = (size_t)bid * 512 + tid, NGT = (size_t)G * 512; (void)lane; (void)gw; (void)NGW; (void)gt; (void)NGT;
#define P_XN(ws) ((bf16*)((ws) + WS_XN))
#define P_XPAD(ws) ((bf16*)((ws) + WS_XP))
#define P_HB(ws) ((bf16*)((ws) + WS_H))
#define P_Y(ws) ((float*)((ws) + WS_Y))
#define P_QB(ws) ((bf16*)((ws) + WS_QB))
#define P_KB(ws) ((bf16*)((ws) + WS_KB))
#define P_VB(ws) ((bf16*)((ws) + WS_VB))
#define P_PB(ws) ((bf16*)((ws) + WS_PB))
#define P_QS(ws) ((float*)((ws) + WS_QS))
#define P_PAR(ws) ((float*)((ws) + WS_PAR))
#define P_POW(ws) ((float*)((ws) + WS_POW))
#define P_KTAB(ws) ((float*)((ws) + WS_KTAB))
#define P_KMAT(ws) ((bf16*)((ws) + WS_KMAT))
#define P_BMAT(ws) ((bf16*)((ws) + WS_BMAT))
#define GRID_BAR() xcd_barrier(bar)
template <int LAYER, int J> __device__ __forceinline__ void ffn_phases(LAS unsigned char* lds, const XcdBarrier& bar) {
    constexpr int layer = LAYER, j = J;
#ifndef NO_FFN
            {
                PHASE_IDS unsigned char* ws = WSP(); const bf16* win_t = (const bf16*)(ws + WS_WIN + (size_t)(layer * 2 + j) * SZ_WIN);
                typedef GD_Plain<1024, 1024, 16> GDT; GDT g{(const char*)P_XN(ws), (const char*)win_t};
                pg8::StaticOrder S; S.init(64, 22, G, bid);
                pg8::EpiSwiGLU E{P_HB(ws), DFF};
                pg8::gemm_phase<GDT, pg8::EpiSwiGLU, pg8::StaticOrder, true>(lds + RING_OFF, g, S, E);
            }
            {
                PHASE_IDS unsigned char* ws = WSP(); const bf16* win_t = (const bf16*)(ws + WS_WIN + (size_t)(layer * 2 + j) * SZ_WIN);
                SkSwiGLU Es{P_HB(ws) + (size_t)MP * DFF};
                skinny_gemm<2, SkSwiGLU>(P_XN(ws) + (size_t)MP * DM, DM, win_t, 1024, 1024, DFF / 16, Es, bid, G, wave, lane);
            }
            GRID_BAR();
            {
                PHASE_IDS unsigned char* ws = WSP(); const bf16* wout_t = (const bf16*)(ws + WS_WOUT + (size_t)(layer * 2 + j) * SZ_WOUT);
                typedef GD_Plain<DFF, DFF, DFF / 64> GDT; GDT g{(const char*)P_HB(ws), (const char*)wout_t};
                pg8::StaticOrder S; S.init(64, 4, G, bid);
                pg8::EpiF32 E{P_Y(ws), DM, nullptr};
                pg8::gemm_phase<GDT, pg8::EpiF32, pg8::StaticOrder, true>(lds + RING_OFF, g, S, E);
            }
            {
                PHASE_IDS unsigned char* ws = WSP(); const bf16* wout_t = (const bf16*)(ws + WS_WOUT + (size_t)(layer * 2 + j) * SZ_WOUT);
                SkF32 Es{P_Y(ws) + (size_t)MP * DM, DM, nullptr};
                skinny_gemm<1, SkF32>(P_HB(ws) + (size_t)MP * DFF, DFF, wout_t, DFF, DFF, DM / 16, Es, bid, G, wave, lane);
            }
            GRID_BAR();
            {
                PHASE_IDS unsigned char* ws = WSP(); const float* NGAIN = INP(I_NG);
                const float* gpost = NGAIN + ((size_t)layer * 8 + 6 * j + 1) * DM;
                const float* gpre = (j == 0) ? NGAIN + ((size_t)layer * 8 + 2) * DM : NGAIN + ((size_t)(layer == 3 ? 3 : layer + 1) * 8 + 0) * DM;
                const int mode = (j == 0) ? ((layer & 1) ? 0 : 1) : (layer == 3 ? 2 : 0);
                thin_rows(gw, NGW, lane, OUTP() + O_X, P_Y(ws), 0.5f, gpost, gpre, P_XN(ws), P_XPAD(ws), mode);
            }
            GRID_BAR();
#endif
}
template <int LAYER> __device__ __forceinline__ void layer_phases(LAS unsigned char* lds, unsigned char* lds_raw, const XcdBarrier& bar) {
    constexpr int layer = LAYER, s = LAYER >> 1;
        if constexpr (!(LAYER & 1)) {
#ifndef NO_SSM
            {
                PHASE_IDS unsigned char* ws = WSP();
                GD_SsmA g{(const char*)P_XPAD(ws), (const char*)(P_BMAT(ws) + (size_t)s * 64 * 256 * 512)};
                pg8::StaticOrder S; S.init(2, 64, G, bid);
                pg8::EpiSsmA E{(float*)(ws + WS_SLOC)};
                pg8::gemm_phase<GD_SsmA, pg8::EpiSsmA, pg8::StaticOrder, true>(lds + RING_OFF, g, S, E);
            }
            {
                PHASE_IDS unsigned char* ws = WSP(); float* out = OUTP();
                const float* PARs = P_PAR(ws) + (size_t)s * 64 * 64 * PAR_STRIDE;
                for (int it = gw; it < 128 * 64; it += NGW)
                    ssm_sample_item(it, lane, P_XN(ws) + (size_t)MP * DM, PARs, INP(I_SRE) + (size_t)s * 128 * 4096, INP(I_SIM) + (size_t)s * 128 * 4096, INP(I_SD) + (size_t)s * DM,
                                    out + O_SSMRE_S + (size_t)s * 128 * 4096, out + O_SSMIM_S + (size_t)s * 128 * 4096, P_QB(ws) + (size_t)MP * DM);
            }
            GRID_BAR();
            {
                PHASE_IDS unsigned char* ws = WSP(); float* out = OUTP();
                const float* PARs = P_PAR(ws) + (size_t)s * 64 * 64 * PAR_STRIDE;
                for (int wg = bid; wg < 256; wg += G) ssm_carry(wg, tid, lds, (const float*)(ws + WS_SLOC), PARs, P_XPAD(ws), out + O_SSMRE_P + (size_t)s * 2 * 4096, out + O_SSMIM_P + (size_t)s * 2 * 4096);
            }
            GRID_BAR();
            {
                PHASE_IDS unsigned char* ws = WSP();
                GD_SsmB g{(const char*)P_XPAD(ws), (const char*)(P_KMAT(ws) + (size_t)s * 64 * 512 * 640)};
                pg8::StaticOrder S; S.init(2, 128, G, bid);
                pg8::EpiSsmB E{P_QB(ws), P_XPAD(ws), INP(I_SD) + (size_t)s * DM};
                pg8::gemm_phase<GD_SsmB, pg8::EpiSsmB, pg8::StaticOrder, true>(lds + RING_OFF, g, S, E);
            }
            GRID_BAR();
            {
                PHASE_IDS unsigned char* ws = WSP(); const bf16* wglu_t = (const bf16*)(ws + WS_WGLU + (size_t)s * 4 * MiB);
                typedef GD_Plain<1024, 1024, 16> GDT; GDT g{(const char*)P_QB(ws), (const char*)wglu_t};
                pg8::StaticOrder S; S.init(64, 8, G, bid);
                pg8::EpiGLU E{P_Y(ws), INP(I_BGLU) + (size_t)s * 2048};
                pg8::gemm_phase<GDT, pg8::EpiGLU, pg8::StaticOrder, true>(lds + RING_OFF, g, S, E);
            }
            {
                PHASE_IDS unsigned char* ws = WSP(); const bf16* wglu_t = (const bf16*)(ws + WS_WGLU + (size_t)s * 4 * MiB);
                SkGLU Es{P_Y(ws) + (size_t)MP * DM, INP(I_BGLU) + (size_t)s * 2048};
                skinny_gemm<2, SkGLU>(P_QB(ws) + (size_t)MP * DM, DM, wglu_t, 1024, 1024, DM / 16, Es, bid, G, wave, lane);
            }
            GRID_BAR();
#endif
        } else {
#ifndef NO_SWA
            {
                PHASE_IDS unsigned char* ws = WSP(); const bf16* wqkv_t = (const bf16*)(ws + WS_WQKV + (size_t)s * 3 * MiB);
                typedef GD_Plain<1024, 1024, 16> GDT; GDT g{(const char*)P_XN(ws), (const char*)wqkv_t};
                pg8::StaticOrder S; S.init(64, 6, G, bid);
                pg8::EpiQKV E{P_QB(ws), P_KB(ws), P_VB(ws), INP(I_BQKV) + (size_t)s * 1536, swa_body::C2};
                pg8::gemm_phase<GDT, pg8::EpiQKV, pg8::StaticOrder, true>(lds + RING_OFF, g, S, E);
            }
            {
                PHASE_IDS unsigned char* ws = WSP(); const bf16* wqkv_t = (const bf16*)(ws + WS_WQKV + (size_t)s * 3 * MiB);
                SkF32 Es{P_QS(ws), 1536, INP(I_BQKV) + (size_t)s * 1536};
                skinny_gemm<1, SkF32>(P_XN(ws) + (size_t)MP * DM, DM, wqkv_t, 1024, 1024, 1536 / 16, Es, bid, G, wave, lane);
            }
            GRID_BAR();
            {
                PHASE_IDS unsigned char* ws = WSP();
                const swa_body::AttnTensors AT{(const swa_body::bf16*)P_QB(ws), (const swa_body::bf16*)P_KB(ws), (const swa_body::bf16*)P_VB(ws), (swa_body::bf16*)P_QB(ws), INP(I_SINK) + (size_t)s * 16};
                const swa_body::StaticOrder S(G, bid);
                swa_body::attn_phase<swa_body::StaticOrder>((char*)lds_raw + RING_OFF, AT, S);
            }
            {
                PHASE_IDS unsigned char* ws = WSP(); float* out = OUTP();
                for (int it = bid; it < 512; it += G)
                    swa_sample_item(it, tid, lds, P_QS(ws), INP(I_CWK) + (size_t)s * 128 * 128 * 256, INP(I_CWV) + (size_t)s * 128 * 128 * 256, INP(I_SINK) + (size_t)s * 16,
                                    out + O_WINK_S + (size_t)s * 128 * 128 * 256, out + O_WINV_S + (size_t)s * 128 * 128 * 256, P_QB(ws) + (size_t)MP * DM);
                const bf16* KB = P_KB(ws); const bf16* VB = P_VB(ws);
                for (size_t e = gt; e < (size_t)2 * 128 * 256; e += NGT) { const int b = (int)(e >> 15), rr = (int)((e >> 8) & 127), c = (int)(e & 255);
                    const size_t src = ((size_t)b * 8192 + 8064 + rr) * 256 + c;
                    out[O_WINK_P + (size_t)s * 65536 + e] = bf2f(KB[src]); out[O_WINV_P + (size_t)s * 65536 + e] = bf2f(VB[src]); }
            }
            GRID_BAR();
            {
                PHASE_IDS unsigned char* ws = WSP(); const bf16* wo_t = (const bf16*)(ws + WS_WAO + (size_t)s * 2 * MiB);
                typedef GD_Plain<1024, 1024, 16> GDT; GDT g{(const char*)P_QB(ws), (const char*)wo_t};
                pg8::StaticOrder S; S.init(64, 4, G, bid);
                pg8::EpiF32 E{P_Y(ws), DM, nullptr};
                pg8::gemm_phase<GDT, pg8::EpiF32, pg8::StaticOrder, true>(lds + RING_OFF, g, S, E);
            }
            {
                PHASE_IDS unsigned char* ws = WSP(); const bf16* wo_t = (const bf16*)(ws + WS_WAO + (size_t)s * 2 * MiB);
                SkF32 Es{P_Y(ws) + (size_t)MP * DM, DM, nullptr};
                skinny_gemm<1, SkF32>(P_QB(ws) + (size_t)MP * DM, DM, wo_t, 1024, 1024, DM / 16, Es, bid, G, wave, lane);
            }
            GRID_BAR();
        #endif
        }
        {
            PHASE_IDS unsigned char* ws = WSP(); const float* NGAIN = INP(I_NG);
            thin_rows(gw, NGW, lane, OUTP() + O_X, P_Y(ws), 1.0f, NGAIN + ((size_t)layer * 8 + 3) * DM, NGAIN + ((size_t)layer * 8 + 4) * DM, P_XN(ws), P_XPAD(ws), 0);
        }
        GRID_BAR();
#ifndef NO_CA
        {
            PHASE_IDS unsigned char* ws = WSP(); const bf16* wq_t = (const bf16*)(ws + WS_CWQ + (size_t)layer * 2 * MiB);
            typedef GD_Plain<1024, 1024, 16> GDT; GDT g{(const char*)P_XN(ws), (const char*)wq_t};
            pg8::StaticOrder S; S.init(64, 4, G, bid);
            pg8::EpiBf16 E{P_QB(ws), DM};
            pg8::gemm_phase<GDT, pg8::EpiBf16, pg8::StaticOrder, true>(lds + RING_OFF, g, S, E);
        }
        {
            PHASE_IDS unsigned char* ws = WSP(); const bf16* wq_t = (const bf16*)(ws + WS_CWQ + (size_t)layer * 2 * MiB);
            SkF32 Es{P_QS(ws), DM, nullptr};
            skinny_gemm<1, SkF32>(P_XN(ws) + (size_t)MP * DM, DM, wq_t, 1024, 1024, DM / 16, Es, bid, G, wave, lane);
        }
        GRID_BAR();
        {
            PHASE_IDS unsigned char* ws = WSP();
            GD_CaS g{(const char*)P_QB(ws), (const char*)((bf16*)(ws + WS_MEMK) + (size_t)layer * 512 * 1024)};
            pg8::StaticOrder S; S.init(64, 4, G, bid);
            pg8::EpiSoftmaxP E{P_PB(ws)};
            pg8::gemm_phase<GD_CaS, pg8::EpiSoftmaxP, pg8::StaticOrder, false>(lds + RING_OFF, g, S, E);
            __syncthreads();
        }
        {
            PHASE_IDS unsigned char* ws = WSP();
            for (int it = bid; it < 512; it += G)
                ca_sample_item(it, tid, lds, P_QS(ws), INP(I_CMK) + (size_t)layer * 128 * 256 * 1024, INP(I_CMV) + (size_t)layer * 128 * 256 * 1024, P_QB(ws) + (size_t)MP * DM);
        }
        GRID_BAR();
        {
            PHASE_IDS unsigned char* ws = WSP();
            GD_CaPV g{(const char*)P_PB(ws), (const char*)((bf16*)(ws + WS_MEMVT) + (size_t)layer * 2 * 4 * 256 * 256)};
            pg8::StaticOrder S; S.init(64, 4, G, bid);
            pg8::EpiBf16 E{P_QB(ws), DM};
            pg8::gemm_phase<GD_CaPV, pg8::EpiBf16, pg8::StaticOrder, true>(lds + RING_OFF, g, S, E);
        }
        GRID_BAR();
        {
            PHASE_IDS unsigned char* ws = WSP(); const bf16* wo_t = (const bf16*)(ws + WS_CWO + (size_t)layer * 2 * MiB);
            typedef GD_Plain<1024, 1024, 16> GDT; GDT g{(const char*)P_QB(ws), (const char*)wo_t};
            pg8::StaticOrder S; S.init(64, 4, G, bid);
            pg8::EpiF32 E{P_Y(ws), DM, nullptr};
            pg8::gemm_phase<GDT, pg8::EpiF32, pg8::StaticOrder, true>(lds + RING_OFF, g, S, E);
        }
        {
            PHASE_IDS unsigned char* ws = WSP(); const bf16* wo_t = (const bf16*)(ws + WS_CWO + (size_t)layer * 2 * MiB);
            SkF32 Es{P_Y(ws) + (size_t)MP * DM, DM, nullptr};
            skinny_gemm<1, SkF32>(P_QB(ws) + (size_t)MP * DM, DM, wo_t, 1024, 1024, DM / 16, Es, bid, G, wave, lane);
        }
        GRID_BAR();
#endif
        {
            PHASE_IDS unsigned char* ws = WSP(); const float* NGAIN = INP(I_NG);
            thin_rows(gw, NGW, lane, OUTP() + O_X, P_Y(ws), 1.0f, NGAIN + ((size_t)layer * 8 + 5) * DM, NGAIN + ((size_t)layer * 8 + 6) * DM, P_XN(ws), P_XPAD(ws), 0);
        }
        GRID_BAR();
}
#undef GRID_BAR
__global__ void __launch_bounds__(NWAVES * 64, 2) mk_fwd(Args args) {
    extern __shared__ __attribute__((aligned(16))) unsigned char lds_raw[];
    LAS unsigned char* lds = (LAS unsigned char*)lds_raw;
    volatile LAS unsigned* MISC = (volatile LAS unsigned*)(lds + MISC_OFF);
    for (int u = threadIdx.x; u < (LDS_BYTES - LDSCTL_OFF) / 4; u += NWAVES * 64) ((LAS unsigned*)(lds + LDSCTL_OFF))[u] = 0u;
    __syncthreads();
    XcdBarrier bar = xcd_barrier_post((unsigned*)(WSP() + WS_CTL) + CW_BAR, MISC + 8);
#define GRID_BAR() xcd_barrier(bar)

#ifndef NO_PR
    {
        LAS float* scr; { PHASE_IDS scr = (LAS float*)(lds + RING_OFF + wave * 16384); (void)bid; }
        for (int layer = 0; layer < 4; ++layer) {
            const int s = layer >> 1;
            for (int mi = 0; mi < 9; ++mi) {
                PHASE_IDS unsigned char* ws = WSP();
                const float* W; bf16* WT; int K, N, mode = 0;
                if (mi < 2) { W = INP(I_FWIN) + (size_t)(layer * 2 + mi) * 1024 * 5632; WT = (bf16*)(ws + WS_WIN + (size_t)(layer * 2 + mi) * SZ_WIN); K = 1024; N = 5632; mode = 1; }
                else if (mi < 4) { W = INP(I_FWOUT) + (size_t)(layer * 2 + mi - 2) * 2816 * 1024; WT = (bf16*)(ws + WS_WOUT + (size_t)(layer * 2 + mi - 2) * SZ_WOUT); K = 2816; N = 1024; }
                else if (mi == 4) { W = INP(I_CWQ) + (size_t)layer * 1024 * 1024; WT = (bf16*)(ws + WS_CWQ + (size_t)layer * 2 * MiB); K = 1024; N = 1024; }
                else if (mi == 5) { W = INP(I_CWO) + (size_t)layer * 1024 * 1024; WT = (bf16*)(ws + WS_CWO + (size_t)layer * 2 * MiB); K = 1024; N = 1024; }
                else if (mi == 6) { W = INP(I_CWKV) + (size_t)layer * 1024 * 2048; WT = (bf16*)(ws + WS_CWKV + (size_t)layer * 4 * MiB); K = 1024; N = 2048; }
                else if (mi == 7) { if (layer & 1) { W = INP(I_WQKV) + (size_t)s * 1024 * 1536; WT = (bf16*)(ws + WS_WQKV + (size_t)s * 3 * MiB); K = 1024; N = 1536; }
                                    else { W = INP(I_WGLU) + (size_t)s * 1024 * 2048; WT = (bf16*)(ws + WS_WGLU + (size_t)s * 4 * MiB); K = 1024; N = 2048; mode = 1; } }
                else { if (!(layer & 1)) continue; W = INP(I_WAO) + (size_t)s * 1024 * 1024; WT = (bf16*)(ws + WS_WAO + (size_t)s * 2 * MiB); K = 1024; N = 1024; }
                const int nitems = (K / 64) * (N / 32);
                for (int it = gw; it < nitems; it += NGW) transpose_item(W, K, N, WT, mode, scr, it, lane);
            }
        }
        { PHASE_IDS unsigned char* ws = WSP(); first_rows(gw, NGW, lane, OUTP() + O_X, INP(I_XP), INP(I_XS), INP(I_NG), P_XN(ws)); }
        {
            PHASE_IDS unsigned char* ws = WSP(); bf16* MEMN = (bf16*)(ws + WS_MEMN); const float* mem = INP(I_MEM); const float* mng = INP(I_MNG);
            for (int row = gw; row < 512; row += NGW) {
                const GAS f32x4* sr = (const GAS f32x4*)(mem + (size_t)row * DM) + lane; f32x4 x[4]; float s2 = 0.f;
#pragma unroll
                for (int j = 0; j < 4; ++j) { x[j] = sr[64 * j]; s2 += (x[j].x * x[j].x + x[j].y * x[j].y) + (x[j].z * x[j].z + x[j].w * x[j].w); }
                const float r2 = 1.f / sqrtf(wave_sum(s2) * (1.f / DM) + EPS);
                for (int l = 0; l < 4; ++l) { GAS unsigned long long* o8 = (GAS unsigned long long*)(MEMN + ((size_t)l * 512 + row) * DM) + lane;
#pragma unroll
                    for (int j = 0; j < 4; ++j) { const f32x4 gg = *(const f32x4*)(mng + (size_t)l * DM + 4 * lane + 256 * j); const f32x4 o = x[j] * gg * r2;
                        o8[64 * j] = (unsigned long long)pk2(o.x, o.y) | ((unsigned long long)pk2(o.z, o.w) << 32); } }
            }
        }
        { PHASE_IDS unsigned char* ws = WSP();
          for (size_t it = gt; it < 8192; it += NGT) ssm_par_item((int)it, INP(I_ARE), INP(I_AIM), INP(I_LDT), INP(I_BRE), INP(I_BIM), INP(I_CRE), INP(I_CIM), P_PAR(ws), P_POW(ws)); }
    }
    GRID_BAR();
    {
        PHASE_IDS unsigned char* ws = WSP(); float* out = OUTP();
        GD_MemKV g{(const char*)(ws + WS_MEMN), (const char*)(ws + WS_CWKV)};
        pg8::StaticOrder S; S.init(8, 8, G, bid);
        pg8::EpiMemKV E{out + O_MEMK_P, out + O_MEMV_P};
        pg8::gemm_phase<GD_MemKV, pg8::EpiMemKV, pg8::StaticOrder, true>(lds + RING_OFF, g, S, E);
    }
    {
        PHASE_IDS unsigned char* ws = WSP();
        for (int it = gw; it < 2 * 64 * 32; it += NGW) ssm_ktab_item(it, lane, P_PAR(ws), P_POW(ws), P_KTAB(ws));
        for (size_t it = gt; it < (size_t)128 * 256 * 64; it += NGT) ssm_bmat_item(it, P_PAR(ws), P_POW(ws), P_BMAT(ws));
        for (size_t it = gt; it < (size_t)128 * 512 * 16; it += NGT) ssm_kmat_state_item(it, P_PAR(ws), P_POW(ws), P_KMAT(ws));
    }
    GRID_BAR();
    {
        PHASE_IDS unsigned char* ws = WSP(); const float* out = OUTP(); bf16* MEMK = (bf16*)(ws + WS_MEMK); bf16* MEMVT = (bf16*)(ws + WS_MEMVT);
        for (size_t it = gt; it < (size_t)128 * 512 * 64; it += NGT) ssm_kmat_toep_item(it, P_KTAB(ws), P_KMAT(ws));
        for (size_t it = gt; it < (size_t)4 * 512 * 128; it += NGT) {
            const float* src = out + O_MEMK_P + it * 8; const f32x4 a = *(const f32x4*)src, b = *(const f32x4*)(src + 4);
            v4u o; o.x = pk2(a.x, a.y); o.y = pk2(a.z, a.w); o.z = pk2(b.x, b.y); o.w = pk2(b.z, b.w); *(GAS v4u*)(MEMK + it * 8) = o; }
        for (size_t it = gt; it < (size_t)4 * 2 * 4 * 32 * 256; it += NGT) {
            const int d = (int)(it & 255), k8 = (int)((it >> 8) & 31), h = (int)((it >> 13) & 3), b = (int)((it >> 15) & 1), l = (int)(it >> 16);
            const float* src = out + O_MEMV_P + ((size_t)l * 512 + b * 256 + k8 * 8) * 1024 + h * 256 + d; float v[8];
#pragma unroll
            for (int e = 0; e < 8; ++e) v[e] = src[(size_t)e * 1024];
            v4u o; o.x = pk2(v[0], v[1]); o.y = pk2(v[2], v[3]); o.z = pk2(v[4], v[5]); o.w = pk2(v[6], v[7]);
            *(GAS v4u*)(MEMVT + ((((size_t)l * 2 + b) * 4 + h) * 256 + d) * 256 + k8 * 8) = o; }
    }
    GRID_BAR();

#endif
    ffn_phases<0, 0>(lds, bar); layer_phases<0>(lds, lds_raw, bar); ffn_phases<0, 1>(lds, bar);
    ffn_phases<1, 0>(lds, bar); layer_phases<1>(lds, lds_raw, bar); ffn_phases<1, 1>(lds, bar);
    ffn_phases<2, 0>(lds, bar); layer_phases<2>(lds, lds_raw, bar); ffn_phases<2, 1>(lds, bar);
    ffn_phases<3, 0>(lds, bar); layer_phases<3>(lds, lds_raw, bar); ffn_phases<3, 1>(lds, bar);
#undef GRID_BAR
    (void)args;
}

extern "C" void kernel_launch(void* const* d_in, const int* in_sizes, int n_in, void* d_out, int out_size, void* d_ws, size_t ws_size, hipStream_t stream) {
    static int grid = 0;
    if (grid == 0) {
        if (n_in != 30 || (size_t)out_size != O_TOTAL || ws_size < WS_END) { fprintf(stderr, "kernel_launch: unexpected shapes (n_in %d, out %d, ws %zu)\n", n_in, out_size, ws_size); grid = -1; return; }
        int dev = 0, cus = 0, per_cu = 0;
        if (hipGetDevice(&dev) != hipSuccess || hipDeviceGetAttribute(&cus, hipDeviceAttributeMultiprocessorCount, dev) != hipSuccess) { grid = -1; return; }
        if (hipFuncSetAttribute((const void*)mk_fwd, hipFuncAttributeMaxDynamicSharedMemorySize, LDS_BYTES) != hipSuccess) { fprintf(stderr, "kernel_launch: hipFuncSetAttribute failed\n"); grid = -1; return; }
        if (hipOccupancyMaxActiveBlocksPerMultiprocessor(&per_cu, (const void*)mk_fwd, NWAVES * 64, LDS_BYTES) != hipSuccess || per_cu < 1) { fprintf(stderr, "kernel_launch: occupancy query says %d blocks per CU\n", per_cu); }
        (void)hipGetLastError();
        grid = cus;
        if (grid != 256) { fprintf(stderr, "kernel_launch: this kernel needs a 256-CU device (got %d)\n", cus); grid = -1; return; }
    }
    if (grid < 0) return;
    (void)in_sizes;
    if (hipMemsetAsync((char*)d_ws + WS_CTL, 0, CTL_ZERO_BYTES, stream) != hipSuccess) return;
    Args a{};
    for (int i = 0; i < 30; ++i) a.in[i] = (const float*)d_in[i];
    a.out = (float*)d_out; a.ws = (unsigned char*)d_ws;
    hipLaunchKernelGGL(mk_fwd, dim3(grid), dim3(NWAVES * 64), LDS_BYTES, stream, a);
}
```
